# Optimizing an MI355X kernel written in HIP

```python
import math
import jax, jax.numpy as jnp
from jax import lax
import numpy as np

D_MODEL = 2048
BATCH = 1
SEQ = 8192
DEPTH = 4

CHUNK = 64
EPS = 1e-6

POOL_WINDOWS = (2, 4, 8, 16)
POOL_GROUPS = len(POOL_WINDOWS)
POOL_WIDTH = D_MODEL // 4
POOL_GC = POOL_WIDTH // POOL_GROUPS

CONV_WIDTH = D_MODEL // 4
CONV_K = 3

ATTN_HEADS = 8
HEAD_DIM = D_MODEL // 16
ATTN_WIDTH = ATTN_HEADS * HEAD_DIM
IDX_HEADS = 8
IDX_DIM = 64
TOPK_MAX = 256
QBLOCK = 128

N_BRANCH = 3
D_FF = 4 * D_MODEL

COL_SIZES = (
    POOL_WIDTH,
    CONV_WIDTH,
    CONV_WIDTH,
    CONV_WIDTH,
    ATTN_WIDTH,
    ATTN_WIDTH,
    ATTN_WIDTH,
    IDX_HEADS * IDX_DIM,
    IDX_DIM,
    IDX_HEADS,
    N_BRANCH * D_MODEL,
)
IN_WIDTH = sum(COL_SIZES)

kernel_name = "hybrid_pool_conv_dsa_block"


def _split_points():
    pts, acc = [], 0
    for c in COL_SIZES[:-1]:
        acc += c
        pts.append(acc)
    return pts


def _rmsnorm(x, g):
    xf = x.astype(jnp.float32)
    y = xf * lax.rsqrt(jnp.mean(xf * xf, axis=-1, keepdims=True) + EPS) * g.astype(jnp.float32)
    return y.astype(x.dtype)


def _multiscale_pool(u, pool_w, pool_scale):
    B, S, P = u.shape
    uf = u.astype(jnp.float32)
    cs = jnp.concatenate([jnp.zeros((B, 1, P), jnp.float32), jnp.cumsum(uf, axis=1)], axis=1)
    t = jnp.arange(S)
    outs = []
    for g, w in enumerate(POOL_WINDOWS):
        sl = slice(g * POOL_GC, (g + 1) * POOL_GC)
        lo = jnp.maximum(t + 1 - w, 0)
        total = cs[:, 1:, sl] - jnp.take(cs[:, :, sl], lo, axis=1)
        cnt = jnp.minimum(t + 1, w).astype(jnp.float32)[None, :, None]
        outs.append(total / cnt - uf[..., sl])
    d = jnp.stack(outs, axis=2)
    y = jnp.einsum('bsgc,gcd->bsgd', d, pool_w.astype(jnp.float32)).reshape(B, S, P)
    return (y * pool_scale.astype(jnp.float32)).astype(u.dtype)


def _short_conv(bg, cg, xin, conv_w):
    S = xin.shape[1]
    z = cg * xin
    zp = jnp.pad(z, ((0, 0), (CONV_K - 1, 0), (0, 0)))
    y = conv_w[0] * zp[:, 0:S]
    for j in range(1, CONV_K):
        y = y + conv_w[j] * zp[:, j:j + S]
    return bg * y


def _sparse_attention(q, k, v, qi, ki, wi, topk):
    B, S = q.shape[0], q.shape[1]
    nb = S // QBLOCK
    key_chunk = jnp.arange(S) // CHUNK

    def per_seq(q1, k1, v1, qi1, ki1, wi1):
        qb = q1.reshape(nb, QBLOCK, ATTN_HEADS, HEAD_DIM)
        qib = qi1.reshape(nb, QBLOCK, IDX_HEADS, IDX_DIM)
        wib = wi1.reshape(nb, QBLOCK, IDX_HEADS)
        starts = jnp.arange(nb) * QBLOCK
        kif = ki1.astype(jnp.float32)

        def block(args):
            qq, qx, ww, t0 = args
            s = jnp.einsum('thd,sd->ths', qx.astype(jnp.float32), kif) * (IDX_DIM ** -0.5)
            score = jnp.einsum('ths,th->ts', jax.nn.relu(s), ww.astype(jnp.float32))
            q_chunk = (t0 + jnp.arange(QBLOCK)) // CHUNK
            adm = key_chunk[None, :] <= q_chunk[:, None]
            score = jnp.where(adm, score, -jnp.inf)
            _, idx = lax.top_k(score, topk)
            valid = jnp.take_along_axis(adm, idx, axis=1)
            kg = k1[idx].astype(jnp.float32)
            vg = v1[idx].astype(jnp.float32)
            logits = jnp.einsum('thd,tkhd->thk', qq.astype(jnp.float32), kg) * (HEAD_DIM ** -0.5)
            logits = jnp.where(valid[:, None, :], logits, -jnp.inf)
            p = jax.nn.softmax(logits, axis=-1)
            o = jnp.einsum('thk,tkhd->thd', p, vg)
            return o.astype(q1.dtype)

        out = lax.map(block, (qb, qib, wib, starts))
        return out.reshape(S, ATTN_HEADS, HEAD_DIM)

    return jax.vmap(per_seq)(q, k, v, qi, ki, wi)


def setup_inputs(seed: int = 0) -> dict:
    key = jax.random.key(seed)
    ks = jax.random.split(key, 16)
    f32 = jnp.float32
    def nrm(k, shape, fan_in):
        return jax.random.normal(k, shape, f32) * (fan_in ** -0.5)
    return {
        "x": jax.random.normal(ks[0], (BATCH, SEQ, D_MODEL), f32),
        "norm1": 1.0 + 0.02 * jax.random.normal(ks[1], (DEPTH, D_MODEL), f32),
        "w_in": nrm(ks[2], (DEPTH, D_MODEL, IN_WIDTH), D_MODEL),
        "pool_w": nrm(ks[3], (DEPTH, POOL_GROUPS, POOL_GC, POOL_GC), POOL_GC),
        "pool_scale": 1.0 + 0.02 * jax.random.normal(ks[4], (DEPTH, POOL_WIDTH), f32),
        "conv_w": nrm(ks[5], (DEPTH, CONV_K, CONV_WIDTH), CONV_K),
        "q_gain": 1.0 + 0.02 * jax.random.normal(ks[6], (DEPTH, HEAD_DIM), f32),
        "k_gain": 1.0 + 0.02 * jax.random.normal(ks[7], (DEPTH, HEAD_DIM), f32),
        "w_pool_out": nrm(ks[8], (DEPTH, POOL_WIDTH, D_MODEL), POOL_WIDTH),
        "w_conv_out": nrm(ks[9], (DEPTH, CONV_WIDTH, D_MODEL), CONV_WIDTH),
        "w_attn_out": nrm(ks[10], (DEPTH, ATTN_WIDTH, D_MODEL), ATTN_WIDTH),
        "w_o": nrm(ks[11], (DEPTH, D_MODEL, D_MODEL), D_MODEL),
        "norm2": 1.0 + 0.02 * jax.random.normal(ks[12], (DEPTH, D_MODEL), f32),
        "w_ff1": nrm(ks[13], (DEPTH, D_MODEL, D_FF), D_MODEL),
        "w_ff2": nrm(ks[14], (DEPTH, D_FF, D_MODEL), D_FF),
    }


def reference(x, norm1, w_in, pool_w, pool_scale, conv_w, q_gain, k_gain,
              w_pool_out, w_conv_out, w_attn_out, w_o, norm2, w_ff1, w_ff2):
    B, S, D = x.shape
    topk = min(TOPK_MAX, S // 4)
    pts = _split_points()
    for l in range(DEPTH):
        h = _rmsnorm(x, norm1[l])
        proj = jnp.einsum('bsd,de->bse', h, w_in[l])
        (u_pool, c_b, c_c, c_x, q, k, v, qi, ki, wi, gate_logits) = jnp.split(proj, pts, axis=-1)

        a = _multiscale_pool(u_pool, pool_w[l], pool_scale[l])
        bconv = _short_conv(c_b, c_c, c_x, conv_w[l])
        q = _rmsnorm(q.reshape(B, S, ATTN_HEADS, HEAD_DIM), q_gain[l])
        k = _rmsnorm(k.reshape(B, S, ATTN_HEADS, HEAD_DIM), k_gain[l])
        v = v.reshape(B, S, ATTN_HEADS, HEAD_DIM)
        qi = qi.reshape(B, S, IDX_HEADS, IDX_DIM)
        wi = wi * (IDX_HEADS ** -0.5)
        c = _sparse_attention(q, k, v, qi, ki, wi, topk).reshape(B, S, ATTN_WIDTH)

        g = jax.nn.sigmoid(gate_logits.astype(jnp.float32)).reshape(B, S, N_BRANCH, D).astype(x.dtype)
        merged = (g[:, :, 0] * jnp.einsum('bsp,pd->bsd', a, w_pool_out[l])
                  + g[:, :, 1] * jnp.einsum('bsp,pd->bsd', bconv, w_conv_out[l])
                  + g[:, :, 2] * jnp.einsum('bsp,pd->bsd', c, w_attn_out[l]))
        x = x + jnp.einsum('bsd,de->bse', merged, w_o[l])

        h2 = _rmsnorm(x, norm2[l])
        f = jnp.square(jax.nn.relu(jnp.einsum('bsd,df->bsf', h2, w_ff1[l])))
        x = x + jnp.einsum('bsf,fd->bsd', f, w_ff2[l])
    return x
```

```cpp
#include <hip/hip_runtime.h>
#include <cstdio>
#include <cstdint>

namespace pg8 {
#define PG8_LAS __attribute__((address_space(3)))
typedef unsigned short bf16_t;
typedef short bf16x8 __attribute__((ext_vector_type(8)));
typedef float f32x4 __attribute__((ext_vector_type(4)));
typedef unsigned u32x4 __attribute__((ext_vector_type(4)));
constexpr int BM = 256, BK = 64, HALF = 128, HTB = HALF * BK * 2, STAGE_BYTES = 8 * HTB, NXCD = 8, WGM = 8;

__host__ __device__ __forceinline__ int lds_byte(int r, int c) { const int st = (r >> 4) * 2 + (c >> 5), rr = r & 15, cc = c & 31, ob = rr * 64 + cc * 2; return st * 1024 + (ob ^ (((ob >> 9) & 1) << 5)); }
__host__ __device__ __forceinline__ void stage_rc(int b, int& R, int& C) { const int st = b / 1024, sb = b % 1024, swz = sb ^ (((sb >> 9) & 1) << 5); R = (st >> 1) * 16 + swz / 64; C = (st & 1) * 32 + (swz % 64) / 2; }
__host__ __device__ __forceinline__ int perm32(int rho) { const int n = rho >> 4, i = rho & 15; return 8 * (i >> 2) + 4 * n + (i & 3); }

struct Unit { int pm, pn; };
struct Gemm { const bf16_t* A; const bf16_t* Bt; int M, N, K, lda, ldb, pad; };

struct StaticOrder {
    int nM, nN, nwg, G, c;
    __host__ __device__ void init(int M, int N, int G_, int c_) { nM = M / BM; nN = N / BM; nwg = nM * nN; G = G_; c = c_; }
    __host__ __device__ bool next(int i, Unit& u) const {
        const long L = (long)i * G + c; if (L >= nwg) return false;
        int wgid = (int)L; { const int q = nwg / NXCD, r = nwg % NXCD, xcd = wgid % NXCD, off = wgid / NXCD; wgid = (xcd < r ? xcd * (q + 1) : r * (q + 1) + (xcd - r) * q) + off; }
        const int nig = WGM * nN, gid = wgid / nig, fm = gid * WGM, gsz = (nM - fm) < WGM ? (nM - fm) : WGM;
        u.pm = fm + ((wgid % nig) % gsz); u.pn = (wgid % nig) / gsz; return true;
    }
    __device__ __forceinline__ void a_ready(const Unit&) const {}
    __device__ __forceinline__ void done(const Unit&) const {}
};

__device__ __forceinline__ int opq_v(int x) { asm volatile("" : "+v"(x)); return x; }
typedef int v4i_t __attribute__((ext_vector_type(4))); typedef int v8i_t __attribute__((ext_vector_type(8)));
__device__ __forceinline__ v8i_t cat8(bf16x8 a, bf16x8 b) { return __builtin_shufflevector(__builtin_bit_cast(v4i_t, a), __builtin_bit_cast(v4i_t, b), 0, 1, 2, 3, 4, 5, 6, 7); }
__device__ __forceinline__ int opq_s(int x) { asm volatile("" : "+s"(x)); return x; }
__device__ __forceinline__ int lane_now() { unsigned m = ~0u; asm volatile("" : "+s"(m)); return (int)__builtin_amdgcn_mbcnt_hi(m, __builtin_amdgcn_mbcnt_lo(m, 0u)); }
__device__ __forceinline__ unsigned cvt_pk_bf16(float lo, float hi) { unsigned r; asm volatile("v_cvt_pk_bf16_f32 %0, %1, %2" : "=v"(r) : "v"(lo), "v"(hi)); return r; }

template <class Epi, class Sched, bool ALIGN_EPI = false, bool SP2 = false, int MODE = 0, int SPLIT = 16, int F8SC = 0x7f7f7f7f>
__device__ __forceinline__ void gemm_phase(PG8_LAS unsigned char* lds, const Gemm g, const Sched& S, const Epi& E, const int tid) {
    const int wid = __builtin_amdgcn_readfirstlane(tid >> 6), lane = tid & 63, wr = wid >> 2, wc = wid & 3, fr = lane & 15, fq = lane >> 4;
    const int K = g.K, nt = K / BK;
    unsigned voffA[2], voffB[2];
#pragma unroll
    for (int i = 0; i < 2; ++i) { int R, C; stage_rc(tid * 16 + i * 8192, R, C); const int Rb = Epi::PERM ? ((R & ~31) + perm32(R & 31)) : R;
        voffA[i] = (unsigned)(R * g.lda + C) * 2u; voffB[i] = (unsigned)(Rb * g.ldb + C) * 2u; }
    const size_t kstep = (size_t)(BK * 2);
    const size_t hstepA = (size_t)HALF * g.lda * 2, hstepB = (size_t)HALF * g.ldb * 2;
    const size_t tstepA = 2 * hstepA, tstepB = 2 * hstepB;
    const unsigned ldsw = (unsigned)wid * 1024u;
    const int aoff = lds_byte(wr * 64 + fr, fq * 8), boff = lds_byte(wc * 32 + fr, fq * 8);
#define PG8_SA(b, h) (((b) * 2 + (h)) * HTB)
#define PG8_SB(b, h) ((4 + (b) * 2 + (h)) * HTB)
#define PG8_STAGE(bufoff, gbase, voff) do { _Pragma("unroll") for (int _i = 0; _i < 2; ++_i) \
        __builtin_amdgcn_global_load_lds((const unsigned*)((const char*)(gbase) + (voff)[_i]), (PG8_LAS unsigned*)(lds + (bufoff) + ldsw + _i * 8192), 16, 0, 0); } while (0)
#define PG8_LD8(p) cat8(*(const PG8_LAS bf16x8*)(p), *(const PG8_LAS bf16x8*)((p) + 1024))
#define PG8_LDA(F8L, dst, b, h) do { _Pragma("unroll") for (int m = 0; m < 4; ++m) { if constexpr (F8L) dst##8[m] = PG8_LD8(lds + PG8_SA(b, h) + aoff + m * 2048); else { _Pragma("unroll") for (int k = 0; k < 2; ++k) dst[m][k] = *(const PG8_LAS bf16x8*)(lds + PG8_SA(b, h) + aoff + m * 2048 + k * 1024); } } } while (0)
#define PG8_LDB(F8L, dst, b, h) do { _Pragma("unroll") for (int n = 0; n < 2; ++n) { if constexpr (F8L) dst##8[n] = PG8_LD8(lds + PG8_SB(b, h) + boff + n * 2048); else { _Pragma("unroll") for (int k = 0; k < 2; ++k) dst[n][k] = *(const PG8_LAS bf16x8*)(lds + PG8_SB(b, h) + boff + n * 2048 + k * 1024); } } } while (0)
#define PG8_MMA(F8L, ai, bj, At, Bt) do { __builtin_amdgcn_s_setprio(1); _Pragma("unroll") for (int m = 0; m < 4; ++m) _Pragma("unroll") for (int n = 0; n < 2; ++n) { \
        if constexpr (F8L) asm volatile("v_mfma_scale_f32_16x16x128_f8f6f4 %0, %1, %2, %0, %3, %3 op_sel_hi:[0,0,0]" : "+v"(acc[ai][bj][m][n]) : "v"(Bt##8[n]), "v"(At##8[m]), "v"(f8scale));   \
        else { _Pragma("unroll") for (int k = 0; k < 2; ++k) acc[ai][bj][m][n] = __builtin_amdgcn_mfma_f32_16x16x32_bf16(Bt[n][k], At[m][k], acc[ai][bj][m][n], 0, 0, 0); } } __builtin_amdgcn_s_setprio(0); } while (0)
#define PG8_WAIT_V(n) asm volatile("s_waitcnt vmcnt(" #n ")" ::: "memory")
#define PG8_WAIT_L(n) asm volatile("s_waitcnt lgkmcnt(" #n ")" ::: "memory")
#define PG8_BAR __builtin_amdgcn_s_barrier()
#define PG8_SCHED __builtin_amdgcn_sched_barrier(0)
    Unit cur, nxt; int ui = 0;
    if (!S.next(0, cur)) return;
    f32x4 acc[2][2][4][2];
#pragma unroll
    for (int a = 0; a < 2; ++a)
#pragma unroll
        for (int b = 0; b < 2; ++b)
#pragma unroll
            for (int m = 0; m < 4; ++m)
#pragma unroll
                for (int n = 0; n < 2; ++n) acc[a][b][m][n] = (f32x4){0.f, 0.f, 0.f, 0.f};
    const int f8scale = opq_v(F8SC);
    bf16x8 At[4][2], B0[2][2], B1[2][2]; v8i_t At8[4], B08[2], B18[2];
    const char* cA = (const char*)g.A + (size_t)cur.pm * tstepA; const char* cB = (const char*)g.Bt + (size_t)cur.pn * tstepB;
    S.a_ready(cur);
    if constexpr (SP2) {
        PG8_STAGE(PG8_SB(0, 0), cB, voffB); PG8_STAGE(PG8_SB(0, 1), cB + hstepB, voffB); PG8_STAGE(PG8_SA(0, 0), cA, voffA); PG8_STAGE(PG8_SA(0, 1), cA + hstepA, voffA);
        if (wr == 1) PG8_BAR;
        PG8_WAIT_V(2); PG8_BAR;
        PG8_STAGE(PG8_SB(1, 0), cB + kstep, voffB); PG8_STAGE(PG8_SA(1, 0), cA + kstep, voffA); PG8_STAGE(PG8_SB(1, 1), cB + hstepB + kstep, voffB);
        PG8_WAIT_V(6); PG8_BAR;
    } else {
        PG8_STAGE(PG8_SB(0, 0), cB, voffB); PG8_STAGE(PG8_SA(0, 0), cA, voffA); PG8_STAGE(PG8_SB(0, 1), cB + hstepB, voffB); PG8_STAGE(PG8_SA(0, 1), cA + hstepA, voffA);
        if (wr == 1) PG8_BAR;
        PG8_WAIT_V(4); PG8_BAR;
        PG8_STAGE(PG8_SB(1, 0), cB + kstep, voffB); PG8_STAGE(PG8_SA(1, 0), cA + kstep, voffA); PG8_STAGE(PG8_SB(1, 1), cB + hstepB + kstep, voffB);
        PG8_WAIT_V(6); PG8_BAR;
    }
    for (;;) {
        const bool has_next = S.next(ui + 1, nxt);
        const char* nA = has_next ? (const char*)g.A + (size_t)nxt.pm * tstepA : cA; const char* nB = has_next ? (const char*)g.Bt + (size_t)nxt.pn * tstepB : cB;
#define PG8_KHEAD() \
            const bool last = (t == nt - 2); \
            const char* a1 = cA + (size_t)(t + 1) * kstep; \
            const char* a2 = last ? nA : cA + (size_t)(t + 2) * kstep; const char* b2 = last ? nB : cB + (size_t)(t + 2) * kstep; \
            const char* a3 = a2 + kstep; const char* b3 = b2 + kstep; \
            if (last && has_next) S.a_ready(nxt); \
            if constexpr (Epi::SEGMENTS) { if (Epi::hook(t)) E.mid(acc, cur, t, wr, wc, fr, fq); }
#define PG8_ITER_SP2(F8L) do { bf16x8 At[4][2], B0[2][2], B1[2][2]; v8i_t At8[4], B08[2], B18[2];     \
            PG8_LDB(F8L, B0, 0, 0); PG8_LDB(F8L, B1, 0, 1); PG8_SCHED; PG8_LDA(F8L, At, 0, 0); PG8_STAGE(PG8_SA(1, 1), a1 + hstepA, voffA); \
            PG8_WAIT_V(8); PG8_WAIT_L(0); PG8_BAR; PG8_MMA(F8L, 0, 0, At, B0); PG8_MMA(F8L, 0, 1, At, B1); PG8_BAR; PG8_SCHED; \
            PG8_LDA(F8L, At, 0, 1); PG8_STAGE(PG8_SB(0, 0), b2, voffB); PG8_STAGE(PG8_SB(0, 1), b2 + hstepB, voffB); PG8_STAGE(PG8_SA(0, 0), a2, voffA); \
            PG8_WAIT_V(8); PG8_WAIT_L(0); PG8_BAR; PG8_MMA(F8L, 1, 0, At, B0); PG8_MMA(F8L, 1, 1, At, B1); PG8_BAR; PG8_SCHED; \
            PG8_LDB(F8L, B0, 1, 0); PG8_LDB(F8L, B1, 1, 1); PG8_SCHED; PG8_LDA(F8L, At, 1, 0); PG8_STAGE(PG8_SA(0, 1), a2 + hstepA, voffA); \
            PG8_WAIT_V(8); PG8_WAIT_L(0); PG8_BAR; PG8_MMA(F8L, 0, 0, At, B0); PG8_MMA(F8L, 0, 1, At, B1); PG8_BAR; PG8_SCHED; \
            PG8_LDA(F8L, At, 1, 1); PG8_STAGE(PG8_SB(1, 0), b3, voffB); PG8_STAGE(PG8_SB(1, 1), b3 + hstepB, voffB); PG8_STAGE(PG8_SA(1, 0), a3, voffA); \
            PG8_WAIT_V(8); PG8_WAIT_L(0); PG8_BAR; PG8_MMA(F8L, 1, 0, At, B0); PG8_MMA(F8L, 1, 1, At, B1); PG8_BAR; PG8_SCHED; } while (0)
        if constexpr (SP2 && MODE == 2) {
            int t = 0;
            for (; t < SPLIT; t += 2) { PG8_KHEAD() PG8_ITER_SP2(false); }
            for (; t < nt; t += 2) { PG8_KHEAD() PG8_ITER_SP2(true); }
        } else if constexpr (SP2) {
            for (int t = 0; t < nt; t += 2) { PG8_KHEAD() if constexpr (MODE == 1) PG8_ITER_SP2(true); else PG8_ITER_SP2(false); }
        } else {
        for (int t = 0; t < nt; t += 2) {
            PG8_KHEAD()
            {
            static_assert(SP2 || MODE == 0, "fp8 K-tiles need the SP2 loop");
            PG8_LDB(false, B0, 0, 0); PG8_SCHED; PG8_LDA(false, At, 0, 0); PG8_STAGE(PG8_SA(1, 1), a1 + hstepA, voffA);
            PG8_WAIT_L(8); PG8_BAR; PG8_WAIT_L(0); PG8_MMA(false, 0, 0, At, B0); PG8_BAR; PG8_SCHED;
            PG8_LDB(false, B1, 0, 1); PG8_STAGE(PG8_SB(0, 0), b2, voffB);
            PG8_BAR; PG8_WAIT_L(0); PG8_MMA(false, 0, 1, At, B1); PG8_BAR;
            PG8_LDA(false, At, 0, 1); PG8_STAGE(PG8_SA(0, 0), a2, voffA);
            PG8_BAR; PG8_WAIT_L(0); PG8_MMA(false, 1, 0, At, B0); PG8_BAR; PG8_SCHED;
            PG8_STAGE(PG8_SB(0, 1), b2 + hstepB, voffB);
            PG8_WAIT_V(6); PG8_BAR; PG8_MMA(false, 1, 1, At, B1); PG8_BAR;
            PG8_LDB(false, B0, 1, 0); PG8_SCHED; PG8_LDA(false, At, 1, 0); PG8_STAGE(PG8_SA(0, 1), a2 + hstepA, voffA);
            PG8_WAIT_L(8); PG8_BAR; PG8_WAIT_L(0); PG8_MMA(false, 0, 0, At, B0); PG8_BAR; PG8_SCHED;
            PG8_LDB(false, B1, 1, 1); PG8_STAGE(PG8_SB(1, 0), b3, voffB);
            PG8_BAR; PG8_WAIT_L(0); PG8_MMA(false, 0, 1, At, B1); PG8_BAR;
            PG8_LDA(false, At, 1, 1); PG8_STAGE(PG8_SA(1, 0), a3, voffA);
            PG8_BAR; PG8_WAIT_L(0); PG8_MMA(false, 1, 0, At, B0); PG8_BAR; PG8_SCHED;
            PG8_STAGE(PG8_SB(1, 1), b3 + hstepB, voffB);
            PG8_WAIT_V(6); PG8_BAR; PG8_MMA(false, 1, 1, At, B1); PG8_BAR;
            }
        }
        }
#undef PG8_ITER_SP2
#undef PG8_KHEAD
        if constexpr (ALIGN_EPI) { if (wr == 0) PG8_BAR; }
        if constexpr (MODE != 0) asm volatile("s_nop 15\n\ts_nop 15" ::: "memory");
        E(acc, cur, wr, wc, fr, fq); S.done(cur);
        if (!has_next) break;
#pragma unroll
        for (int a = 0; a < 2; ++a)
#pragma unroll
            for (int b = 0; b < 2; ++b)
#pragma unroll
                for (int m = 0; m < 4; ++m)
#pragma unroll
                    for (int n = 0; n < 2; ++n) acc[a][b][m][n] = (f32x4){0.f, 0.f, 0.f, 0.f};
        cur = nxt; cA = nA; cB = nB; ++ui;
        if constexpr (ALIGN_EPI) { if (wr == 1) PG8_BAR; }
    }
    PG8_WAIT_V(0);
    if constexpr (!ALIGN_EPI) { if (wr == 0) PG8_BAR; }
    PG8_BAR;
#undef PG8_SA
#undef PG8_SB
#undef PG8_STAGE
#undef PG8_LDA
#undef PG8_LDB
#undef PG8_MMA
#undef PG8_WAIT_V
#undef PG8_WAIT_L
#undef PG8_BAR
#undef PG8_SCHED
}
}

constexpr int SEQ = 8192, DM = 2048, DEPTH = 4, DFF = 8192;
constexpr int FF_B16 = 6144, FF_F8 = DFF - FF_B16, FROW = FF_B16 + FF_F8 / 2;
constexpr int INW = 11848;
constexpr int INW_PAD = 12032;
constexpr int GATE_REF0 = 5704, GATE_PAD0 = 5888;
constexpr float EPS = 1e-6f;

typedef unsigned short bf16;
typedef unsigned v4u __attribute__((ext_vector_type(4)));
typedef unsigned v2u __attribute__((ext_vector_type(2)));
typedef float f32x4 __attribute__((ext_vector_type(4)));
typedef float f32x16 __attribute__((ext_vector_type(16)));
typedef short bf16x8 __attribute__((ext_vector_type(8)));
#define LAS __attribute__((address_space(3)))

constexpr size_t MiB = 1u << 20;
constexpr size_t WS_CTL = 0;
constexpr size_t WS_W = 2 * MiB;
constexpr size_t WL_WIN = 0, WL_WCAT = 47 * MiB, WL_WO = 55 * MiB, WL_W1 = 63 * MiB, WL_W2 = 95 * MiB, WL_STRIDE = 127 * MiB;
constexpr size_t WS_X = 512 * MiB;
constexpr size_t WS_HB = 576 * MiB;
constexpr size_t WS_PC = 608 * MiB;
constexpr size_t WS_Q = 640 * MiB, WS_K = 656 * MiB, WS_V = 672 * MiB;
constexpr size_t WS_QI = 688 * MiB;
constexpr size_t WS_KI = 696 * MiB;
constexpr size_t WS_WI = 697 * MiB;
constexpr size_t WS_ACAT = 704 * MiB;
constexpr size_t WS_G = 736 * MiB;
constexpr size_t WS_MASK = 832 * MiB;
constexpr size_t WS_MF = 840 * MiB;
constexpr size_t WS_MB = 904 * MiB;
constexpr size_t WS_S = 936 * MiB;
constexpr size_t WS_F = 936 * MiB;
constexpr size_t WS_X8 = 1192 * MiB;
constexpr size_t WS_WG8 = 1208 * MiB;
constexpr size_t WS_END = 1280 * MiB;
constexpr int NB16 = 2816;
constexpr int MROW = 1536;
constexpr int NF8 = 9216;

__device__ __forceinline__ unsigned f2bf(float f) { unsigned u = __builtin_bit_cast(unsigned, f); return (u + 0x7fffu + ((u >> 16) & 1u)) >> 16; }
__device__ __forceinline__ unsigned pk2(float lo, float hi) { return f2bf(lo) | (f2bf(hi) << 16); }
__device__ __forceinline__ float bflo(unsigned w) { return __builtin_bit_cast(float, w << 16); }
__device__ __forceinline__ float bfhi(unsigned w) { return __builtin_bit_cast(float, w & 0xffff0000u); }
__device__ __forceinline__ float shx(float v, int lane, int o) { return __builtin_bit_cast(float, __builtin_amdgcn_ds_bpermute((lane ^ o) << 2, __builtin_bit_cast(int, v))); }
__device__ __forceinline__ int shi(int v, int src) { return __builtin_amdgcn_ds_bpermute(src << 2, v); }
__device__ __forceinline__ float wave_sum(float v, int lane) {
#pragma unroll
    for (int o = 1; o < 64; o <<= 1) v += shx(v, lane, o);
    return v;
}

__device__ __forceinline__ float f8clamp(float v) { return __builtin_amdgcn_fmed3f(v, -448.f, 448.f); }
__device__ __forceinline__ unsigned u8x4(float a, float b, float c, float d) {
    unsigned w = 0; w = __builtin_amdgcn_cvt_pk_u8_f32(fmaxf(__builtin_rintf(a * 255.f), 1.f), 0, w); w = __builtin_amdgcn_cvt_pk_u8_f32(fmaxf(__builtin_rintf(b * 255.f), 1.f), 1, w);
    w = __builtin_amdgcn_cvt_pk_u8_f32(fmaxf(__builtin_rintf(c * 255.f), 1.f), 2, w); w = __builtin_amdgcn_cvt_pk_u8_f32(fmaxf(__builtin_rintf(d * 255.f), 1.f), 3, w); return w; }
__device__ __forceinline__ float ub0(unsigned w) { return (float)(w & 255u); }
__device__ __forceinline__ float ub1(unsigned w) { return (float)((w >> 8) & 255u); }
__device__ __forceinline__ float ub2(unsigned w) { return (float)((w >> 16) & 255u); }
__device__ __forceinline__ float ub3(unsigned w) { return (float)(w >> 24); }
__device__ __forceinline__ unsigned f8x4(float a, float b, float c, float d) { int w = 0; w = __builtin_amdgcn_cvt_pk_fp8_f32(f8clamp(a), f8clamp(b), w, false); w = __builtin_amdgcn_cvt_pk_fp8_f32(f8clamp(c), f8clamp(d), w, true); return (unsigned)w; }
__device__ __forceinline__ float row_rinv(const float* rss) {
    const f32x4 a = *(const f32x4*)rss, b = *(const f32x4*)(rss + 4);
    return 1.0f / sqrtf((((a.x + a.y) + (a.z + a.w)) + ((b.x + b.y) + (b.z + b.w))) * (1.f / DM) + EPS);
}

struct EpiInProj {
    static constexpr bool PERM = true, SEGMENTS = false;
    bf16 *PC, *Q, *K, *V, *QI, *KI, *G; float* WI; const float* RSS; LAS float* rl;
    __device__ __forceinline__ void operator()(const pg8::f32x4 (&acc_in)[2][2][4][2], const pg8::Unit& u, int wr, int wc, int fr, int fq) const {
        const int row0 = u.pm * 256 + wr * 64 + fr, cl = wc * 32 + 8 * fq, pn = u.pn;
        pg8::f32x4 acc[2][2][4][2];
        if (wr == 0) rl[wc * 64 + fr + 16 * fq] = row_rinv(RSS + (size_t)(u.pm * 256 + wc * 64 + fr + 16 * fq) * 8);
        asm volatile("s_waitcnt lgkmcnt(0)" ::: "memory"); __builtin_amdgcn_s_barrier(); asm volatile("" ::: "memory");
#pragma unroll
        for (int ai = 0; ai < 2; ++ai)
#pragma unroll
            for (int m = 0; m < 4; ++m) { const float ri = rl[wr * 64 + ai * 128 + m * 16 + fr];
#pragma unroll
                for (int bj = 0; bj < 2; ++bj)
#pragma unroll
                    for (int n = 0; n < 2; ++n) acc[ai][bj][m][n] = acc_in[ai][bj][m][n] * ri; }
        if (pn == 10) {
#pragma unroll
            for (int ai = 0; ai < 2; ++ai)
#pragma unroll
                for (int m = 0; m < 4; ++m) { const int row = row0 + ai * 128 + m * 16; const pg8::f32x4 v0 = acc[ai][0][m][0], v1 = acc[ai][0][m][1];
                    if (cl < 64) { v4u w; w.x = pg8::cvt_pk_bf16(v0[0], v0[1]); w.y = pg8::cvt_pk_bf16(v0[2], v0[3]); w.z = pg8::cvt_pk_bf16(v1[0], v1[1]); w.w = pg8::cvt_pk_bf16(v1[2], v1[3]);
                        *(v4u*)(KI + (size_t)row * 64 + cl) = w; }
                    else if (cl == 64) { *(f32x4*)(WI + (size_t)row * 8) = v0; *(f32x4*)(WI + (size_t)row * 8 + 4) = v1; } }
            return;
        }
        bf16* base; int ldc, colt; const bool sig = false;
        if (pn < 8) { base = PC; ldc = 2048; colt = pn * 256; }
        else { base = QI; ldc = 512; colt = (pn - 8) * 256; }
#pragma unroll
        for (int ai = 0; ai < 2; ++ai)
#pragma unroll
            for (int m = 0; m < 4; ++m) { bf16* rowp = base + (size_t)(row0 + ai * 128 + m * 16) * ldc + colt + cl;
#pragma unroll
                for (int bj = 0; bj < 2; ++bj) { pg8::f32x4 v0 = acc[ai][bj][m][0], v1 = acc[ai][bj][m][1];
                    if (sig) {
#pragma unroll
                        for (int j = 0; j < 4; ++j) { v0[j] = __builtin_amdgcn_rcpf(1.f + __builtin_amdgcn_exp2f(-1.44269504f * v0[j])); v1[j] = __builtin_amdgcn_rcpf(1.f + __builtin_amdgcn_exp2f(-1.44269504f * v1[j])); } }
                    v4u w; w.x = pg8::cvt_pk_bf16(v0[0], v0[1]); w.y = pg8::cvt_pk_bf16(v0[2], v0[3]); w.z = pg8::cvt_pk_bf16(v1[0], v1[1]); w.w = pg8::cvt_pk_bf16(v1[2], v1[3]);
                    *(v4u*)(rowp + bj * 128) = w; } }
    }
};
struct EpiGate {
    static constexpr bool PERM = true, SEGMENTS = false;
    bf16 *Q, *K, *V, *G; const float* RSS; LAS float* rl; unsigned char* Q8; const float* qg; const float* kg; LAS float* xq;
    __device__ __forceinline__ void qk_tile(const pg8::f32x4 (&acc_in)[2][2][4][2], const pg8::Unit& u, int wr, int wc, int fr, int fq) const {
        const int pn = u.pn, lane = fr + 16 * fq, cl = wc * 32 + 8 * fq;
        pg8::f32x4 a[2][2][4][2]; float ss[2][4][2];
#pragma unroll
        for (int ai = 0; ai < 2; ++ai)
#pragma unroll
            for (int m = 0; m < 4; ++m) { const float rs = rl[wr * 64 + ai * 128 + m * 16 + fr] * (-1.0f / 1.44269504f);
#pragma unroll
                for (int bj = 0; bj < 2; ++bj) { const pg8::f32x4 v0 = acc_in[ai][bj][m][0] * rs, v1 = acc_in[ai][bj][m][1] * rs; a[ai][bj][m][0] = v0; a[ai][bj][m][1] = v1;
                    float s = (v0[0] * v0[0] + v0[1] * v0[1]) + (v0[2] * v0[2] + v0[3] * v0[3]) + (v1[0] * v1[0] + v1[1] * v1[1]) + (v1[2] * v1[2] + v1[3] * v1[3]);
                    s += shx(s, lane, 16); s += shx(s, lane, 32); ss[ai][m][bj] = s; } }
        if (fq == 0) {
#pragma unroll
            for (int ai = 0; ai < 2; ++ai)
#pragma unroll
                for (int m = 0; m < 4; ++m)
#pragma unroll
                    for (int bj = 0; bj < 2; ++bj) xq[((wr * 64 + ai * 128 + m * 16 + fr) * 2 + bj) * 4 + wc] = ss[ai][m][bj]; }
        asm volatile("s_waitcnt lgkmcnt(0)" ::: "memory"); __builtin_amdgcn_s_barrier(); asm volatile("" ::: "memory");
        const float* gn = (pn < 4 ? qg : kg) + cl; const f32x4 g0 = *(const f32x4*)gn, g1 = *(const f32x4*)(gn + 4);
        unsigned char* dst = Q8 + (size_t)(pn >> 2) * (8 * MiB) + (size_t)(u.pm * 256 + wr * 64 + fr) * 1024 + (pn & 3) * 256 + cl;
#pragma unroll
        for (int ai = 0; ai < 2; ++ai)
#pragma unroll
            for (int m = 0; m < 4; ++m)
#pragma unroll
                for (int bj = 0; bj < 2; ++bj) { const pg8::f32x4 p = *(const LAS pg8::f32x4*)(xq + ((wr * 64 + ai * 128 + m * 16 + fr) * 2 + bj) * 4);
                    const float rinv = 1.0f / sqrtf(((p[0] + p[1]) + (p[2] + p[3])) * (1.f / 128.f) + EPS);
                    const pg8::f32x4 v0 = a[ai][bj][m][0] * rinv, v1 = a[ai][bj][m][1] * rinv;
                    v2u w; w.x = f8x4(v0[0] * g0[0], v0[1] * g0[1], v0[2] * g0[2], v0[3] * g0[3]); w.y = f8x4(v1[0] * g1[0], v1[1] * g1[1], v1[2] * g1[2], v1[3] * g1[3]);
                    *(v2u*)(dst + (size_t)(ai * 128 + m * 16) * 1024 + bj * 128) = w; }
    }
    __device__ __forceinline__ void operator()(const pg8::f32x4 (&acc)[2][2][4][2], const pg8::Unit& u, int wr, int wc, int fr, int fq) const {
        const int row0 = u.pm * 256 + wr * 64 + fr, pn = u.pn; const bool gate = pn >= 12;
        static_assert(WS_K - WS_Q == WS_V - WS_K, "q|k|v buffers equally spaced");
        bf16* base = gate ? G + (pn - 12) * 256 : Q + (size_t)(pn >> 2) * ((WS_K - WS_Q) / 2) + (pn & 3) * 256; const int ldc = gate ? 6144 : 1024; base += wc * 32 + 8 * fq;
        if (wr == 0) rl[wc * 64 + fr + 16 * fq] = row_rinv(RSS + (size_t)(u.pm * 256 + wc * 64 + fr + 16 * fq) * 8) * (-1.44269504f / 32.f);
        asm volatile("s_waitcnt lgkmcnt(0)" ::: "memory"); __builtin_amdgcn_s_barrier(); asm volatile("" ::: "memory");
        if (pn < 8) { qk_tile(acc, u, wr, wc, fr, fq); return; }
#pragma unroll
        for (int ai = 0; ai < 2; ++ai)
#pragma unroll
            for (int m = 0; m < 4; ++m) { const int row = row0 + ai * 128 + m * 16; const float ri = rl[wr * 64 + ai * 128 + m * 16 + fr];
                bf16* rowp = base + (size_t)row * ldc;
#pragma unroll
                for (int bj = 0; bj < 2; ++bj) { pg8::f32x4 v0 = acc[ai][bj][m][0], v1 = acc[ai][bj][m][1];
                    if (gate) {
#pragma unroll
                        for (int j = 0; j < 4; ++j) { v0[j] = __builtin_amdgcn_rcpf(1.f + __builtin_amdgcn_exp2f(ri * v0[j])); v1[j] = __builtin_amdgcn_rcpf(1.f + __builtin_amdgcn_exp2f(ri * v1[j])); }
                        v2u w8; w8.x = u8x4(v0[0], v0[1], v0[2], v0[3]); w8.y = u8x4(v1[0], v1[1], v1[2], v1[3]);
                        *(v2u*)((unsigned char*)G + (size_t)row * 6144 + (pn - 12) * 256 + wc * 32 + 8 * fq + bj * 128) = w8; continue; }
                    else { const float rs = ri * (-1.0f / 1.44269504f); v0 *= rs; v1 *= rs; }
                    v4u w; w.x = pg8::cvt_pk_bf16(v0[0], v0[1]); w.y = pg8::cvt_pk_bf16(v0[2], v0[3]); w.z = pg8::cvt_pk_bf16(v1[0], v1[1]); w.w = pg8::cvt_pk_bf16(v1[2], v1[3]);
                    *(v4u*)(rowp + bj * 128) = w; } }
    }
};
__device__ __forceinline__ float gclamp(float g) { return fmaxf(g, 1e-20f); }
struct EpiMerge {
    static constexpr bool PERM = true, SEGMENTS = true;
    static __device__ __forceinline__ bool hook(int t) { return t == 8 || t == 16; }
    const bf16* G; bf16* MB;
    __device__ __forceinline__ void mid(pg8::f32x4 (&acc)[2][2][4][2], const pg8::Unit& u, int t, int wr, int wc, int fr, int fq) const {
        const int row0 = pg8::opq_v(u.pm * 256 + wr * 64 + fr), col0 = u.pn * 256 + wc * 32 + 8 * fq, b = (t == 8) ? 0 : 1; const float sc = (t == 8) ? 1.f : 512.f;
        v2u gn[2][2][2], gd[2][2][2];
#define MRG_LD(q_, buf_) do { _Pragma("unroll") for (int mm = 0; mm < 2; ++mm) { const unsigned char* gp = (const unsigned char*)G + (size_t)(row0 + ((q_) >> 1) * 128 + (((q_) & 1) * 2 + mm) * 16) * 6144 + b * 2048 + col0; \
            _Pragma("unroll") for (int bj = 0; bj < 2; ++bj) { gn[buf_][mm][bj] = *(const v2u*)(gp + bj * 128); gd[buf_][mm][bj] = *(const v2u*)(gp + 2048 + bj * 128); } } } while (0)
        MRG_LD(0, 0);
#pragma unroll
        for (int q = 0; q < 4; ++q) { const int ai = q >> 1, mp = q & 1, bf = q & 1;
            if (q + 1 < 4) { if (bf == 0) MRG_LD(q + 1, 1); else MRG_LD(q + 1, 0); }
#pragma unroll
            for (int mm = 0; mm < 2; ++mm)
#pragma unroll
                for (int bj = 0; bj < 2; ++bj) { const v2u n4 = gn[bf][mm][bj], d4 = gd[bf][mm][bj];
                    pg8::f32x4& v0 = acc[ai][bj][mp * 2 + mm][0]; pg8::f32x4& v1 = acc[ai][bj][mp * 2 + mm][1];
                    v0[0] *= sc * ub0(n4.x) * __builtin_amdgcn_rcpf(ub0(d4.x)); v0[1] *= sc * ub1(n4.x) * __builtin_amdgcn_rcpf(ub1(d4.x));
                    v0[2] *= sc * ub2(n4.x) * __builtin_amdgcn_rcpf(ub2(d4.x)); v0[3] *= sc * ub3(n4.x) * __builtin_amdgcn_rcpf(ub3(d4.x));
                    v1[0] *= sc * ub0(n4.y) * __builtin_amdgcn_rcpf(ub0(d4.y)); v1[1] *= sc * ub1(n4.y) * __builtin_amdgcn_rcpf(ub1(d4.y));
                    v1[2] *= sc * ub2(n4.y) * __builtin_amdgcn_rcpf(ub2(d4.y)); v1[3] *= sc * ub3(n4.y) * __builtin_amdgcn_rcpf(ub3(d4.y));
                    asm volatile("" : "+v"(v0), "+v"(v1) :: "memory"); } }
#undef MRG_LD
    }
    __device__ __forceinline__ void operator()(const pg8::f32x4 (&acc)[2][2][4][2], const pg8::Unit& u, int wr, int wc, int fr, int fq) const {
        const int row0 = u.pm * 256 + wr * 64 + fr, col0 = u.pn * 256 + wc * 32 + 8 * fq;
#pragma unroll
        for (int ai = 0; ai < 2; ++ai)
#pragma unroll
            for (int m = 0; m < 4; ++m) { const int row = row0 + ai * 128 + m * 16;
#pragma unroll
                for (int bj = 0; bj < 2; ++bj) { const int c = col0 + bj * 128;
                    const v2u gw = *(const v2u*)((const unsigned char*)G + (size_t)row * 6144 + 2 * 2048 + c);
                    pg8::f32x4 v0 = acc[ai][bj][m][0], v1 = acc[ai][bj][m][1];
                    constexpr float IS = 1.f / (512.f * 255.f);
                    v0[0] *= IS * ub0(gw.x); v0[1] *= IS * ub1(gw.x); v0[2] *= IS * ub2(gw.x); v0[3] *= IS * ub3(gw.x);
                    v1[0] *= IS * ub0(gw.y); v1[1] *= IS * ub1(gw.y); v1[2] *= IS * ub2(gw.y); v1[3] *= IS * ub3(gw.y);
                    v4u w; w.x = pg8::cvt_pk_bf16(v0[0], v0[1]); w.y = pg8::cvt_pk_bf16(v0[2], v0[3]); w.z = pg8::cvt_pk_bf16(v1[0], v1[1]); w.w = pg8::cvt_pk_bf16(v1[2], v1[3]);
                    *(v4u*)(MB + (size_t)row * 2048 + c) = w; } }
    }
};
struct EpiResid {
    static constexpr bool PERM = false, SEGMENTS = false;
    const float* base32; const bf16* base16; float* out32; bf16* XB; unsigned char* X8; float* RSS; LAS float* xl;
    __device__ __forceinline__ void operator()(const pg8::f32x4 (&acc)[2][2][4][2], const pg8::Unit& u, int wr, int wc, int fr, int fq) const {
        const int row0 = u.pm * 256 + wr * 64 + fr, col0 = u.pn * 256 + wc * 32 + 4 * fq, lane = fr + 16 * fq;
#pragma unroll
        for (int ai = 0; ai < 2; ++ai) {
            pg8::f32x4 bb[4][2][2];
            if (base32) {
#pragma unroll
                for (int m = 0; m < 4; ++m)
#pragma unroll
                    for (int bj = 0; bj < 2; ++bj)
#pragma unroll
                        for (int n = 0; n < 2; ++n) bb[m][bj][n] = *(const pg8::f32x4*)(base32 + (size_t)(row0 + ai * 128 + m * 16) * DM + col0 + bj * 128 + n * 16);
            } else {
                v2u rw[4][2][2];
#pragma unroll
                for (int m = 0; m < 4; ++m)
#pragma unroll
                    for (int bj = 0; bj < 2; ++bj)
#pragma unroll
                        for (int n = 0; n < 2; ++n) rw[m][bj][n] = *(const v2u*)(base16 + (size_t)(row0 + ai * 128 + m * 16) * DM + col0 + bj * 128 + n * 16);
#pragma unroll
                for (int m = 0; m < 4; ++m)
#pragma unroll
                    for (int bj = 0; bj < 2; ++bj)
#pragma unroll
                        for (int n = 0; n < 2; ++n) bb[m][bj][n] = (pg8::f32x4){bflo(rw[m][bj][n].x), bfhi(rw[m][bj][n].x), bflo(rw[m][bj][n].y), bfhi(rw[m][bj][n].y)};
            }
#pragma unroll
            for (int m = 0; m < 4; ++m) { const size_t off = (size_t)(row0 + ai * 128 + m * 16) * DM + col0; float ss = 0.f;
#pragma unroll
                for (int bj = 0; bj < 2; ++bj)
#pragma unroll
                    for (int n = 0; n < 2; ++n) { const pg8::f32x4 o = bb[m][bj][n] + acc[ai][bj][m][n];
                        ss += (o[0] * o[0] + o[1] * o[1]) + (o[2] * o[2] + o[3] * o[3]);
                        if (out32) *(pg8::f32x4*)(out32 + off + bj * 128 + n * 16) = o;
                        if (XB) { v2u w; w.x = pg8::cvt_pk_bf16(o[0], o[1]); w.y = pg8::cvt_pk_bf16(o[2], o[3]); *(v2u*)(XB + off + bj * 128 + n * 16) = w; }
                        if (X8) *(unsigned*)(X8 + off + bj * 128 + n * 16) = f8x4(o[0], o[1], o[2], o[3]); }
                ss += shx(ss, lane, 16); ss += shx(ss, lane, 32);
                if (fq == 0) xl[(wr * 64 + ai * 128 + m * 16 + fr) * 4 + wc] = ss; } }
        asm volatile("s_waitcnt lgkmcnt(0)" ::: "memory"); __builtin_amdgcn_s_barrier(); asm volatile("" ::: "memory");
        if (wc == 0 && fq == 0) {
#pragma unroll
            for (int ai = 0; ai < 2; ++ai)
#pragma unroll
                for (int m = 0; m < 4; ++m) { const int rl = wr * 64 + ai * 128 + m * 16 + fr; const pg8::f32x4 p = *(const LAS pg8::f32x4*)(xl + rl * 4);
                    RSS[(size_t)(u.pm * 256 + rl) * 8 + u.pn] = (p[0] + p[1]) + (p[2] + p[3]); } }
    }
};
struct EpiRelu2 {
    static constexpr bool PERM = true, SEGMENTS = false;
    bf16* O; const float* RSS; LAS float* rl; int ldc, pad;
    __device__ __forceinline__ void operator()(const pg8::f32x4 (&acc)[2][2][4][2], const pg8::Unit& u, int wr, int wc, int fr, int fq) const {
        const int row0 = u.pm * 256 + wr * 64 + fr, col0 = u.pn * 256 + wc * 32 + 8 * fq;
        if (wr == 0) rl[wc * 64 + fr + 16 * fq] = row_rinv(RSS + (size_t)(u.pm * 256 + wc * 64 + fr + 16 * fq) * 8);
        asm volatile("s_waitcnt lgkmcnt(0)" ::: "memory"); __builtin_amdgcn_s_barrier(); asm volatile("" ::: "memory");
#pragma unroll
        for (int ai = 0; ai < 2; ++ai)
#pragma unroll
            for (int m = 0; m < 4; ++m) { bf16* rowp = O + (size_t)(row0 + ai * 128 + m * 16) * ldc + col0; const float ri = rl[wr * 64 + ai * 128 + m * 16 + fr];
#pragma unroll
                for (int bj = 0; bj < 2; ++bj) { pg8::f32x4 v0 = acc[ai][bj][m][0] * ri, v1 = acc[ai][bj][m][1] * ri;
#pragma unroll
                    for (int j = 0; j < 4; ++j) { const float a = fmaxf(v0[j], 0.f), b = fmaxf(v1[j], 0.f); v0[j] = a * a; v1[j] = b * b; }
                    if (u.pn * 256 >= FF_B16) {
                        v2u w8; w8.x = f8x4(v0[0] * 8.f, v0[1] * 8.f, v0[2] * 8.f, v0[3] * 8.f); w8.y = f8x4(v1[0] * 8.f, v1[1] * 8.f, v1[2] * 8.f, v1[3] * 8.f);
                        *(v2u*)((unsigned char*)O + (size_t)(row0 + ai * 128 + m * 16) * (ldc * 2) + FF_B16 * 2 + (col0 - FF_B16) + bj * 128) = w8; continue; }
                    v4u w; w.x = pg8::cvt_pk_bf16(v0[0], v0[1]); w.y = pg8::cvt_pk_bf16(v0[2], v0[3]); w.z = pg8::cvt_pk_bf16(v1[0], v1[1]); w.w = pg8::cvt_pk_bf16(v1[2], v1[3]);
                    *(v4u*)(rowp + bj * 128) = w; } }
    }
};
__device__ __forceinline__ int colmap_in(int np) { return np < 2048 ? np : (np < 2560 ? np + 3072 : (np < 2632 ? np + 3072 : -1)); }
__device__ __forceinline__ int colmap_f8(int np) { return np < 3072 ? np + 2048 : np - 3072 + GATE_REF0; }
template <bool INMAP>
__device__ __forceinline__ void transpose_item(const float* W, int Nsrc, bf16* WT, int ldk, int koff, int k0, int n0, int lane, const float* gain = nullptr) {
    const int nq = lane & 15, kg = lane >> 4, np = n0 + 4 * nq; const int sc = INMAP ? colmap_in(np) : np;
    f32x4 v[16];
    if (sc >= 0) { const float* src = W + (size_t)(k0 + 16 * kg) * Nsrc + sc;
#pragma unroll
        for (int i = 0; i < 16; ++i) v[i] = __builtin_nontemporal_load((const f32x4*)(src + (size_t)i * Nsrc));
        if (gain) {
#pragma unroll
            for (int i = 0; i < 16; ++i) v[i] *= gain[k0 + 16 * kg + i]; } }
    else {
#pragma unroll
        for (int i = 0; i < 16; ++i) v[i] = (f32x4){0.f, 0.f, 0.f, 0.f}; }
#pragma unroll
    for (int j = 0; j < 4; ++j) { bf16* dst = WT + (size_t)(np + j) * ldk + koff + k0 + 16 * kg;
        v4u o0, o1;
        o0.x = pk2(v[0][j], v[1][j]); o0.y = pk2(v[2][j], v[3][j]); o0.z = pk2(v[4][j], v[5][j]); o0.w = pk2(v[6][j], v[7][j]);
        o1.x = pk2(v[8][j], v[9][j]); o1.y = pk2(v[10][j], v[11][j]); o1.z = pk2(v[12][j], v[13][j]); o1.w = pk2(v[14][j], v[15][j]);
        *(v4u*)dst = o0; *(v4u*)(dst + 8) = o1; }
}
template <bool INQ>
__device__ __forceinline__ void transpose_item_f8(const float* W, int Nsrc, unsigned char* W8, size_t rowb, int koffb, int k0, int n0, int lane, const float* gain, float scale) {
    const int nq = lane & 15, kg = lane >> 4, np = n0 + 4 * nq;
    const float* src = W + (size_t)(k0 + 16 * kg) * Nsrc + (INQ ? colmap_f8(np) : np);
    f32x4 v[16];
#pragma unroll
    for (int i = 0; i < 16; ++i) v[i] = __builtin_nontemporal_load((const f32x4*)(src + (size_t)i * Nsrc));
#pragma unroll
    for (int i = 0; i < 16; ++i) v[i] *= (gain ? gain[k0 + 16 * kg + i] : 1.f) * scale;
#pragma unroll
    for (int j = 0; j < 4; ++j) { v4u o; o.x = f8x4(v[0][j], v[1][j], v[2][j], v[3][j]); o.y = f8x4(v[4][j], v[5][j], v[6][j], v[7][j]); o.z = f8x4(v[8][j], v[9][j], v[10][j], v[11][j]); o.w = f8x4(v[12][j], v[13][j], v[14][j], v[15][j]);
        *(v4u*)(W8 + (size_t)(np + j) * rowb + koffb + k0 + 16 * kg) = o; }
}
struct ConvArgs { const float *w_in, *w_conv_out, *w_attn_out, *w_o, *w_ff1, *w_ff2, *norm1, *norm2; unsigned char* ws; };
__device__ __forceinline__ void convert_weights(const ConvArgs& a, int gw, int NGW, int lane) {
    constexpr int I_IN = (DM / 64) * (NB16 / 64), I_G8 = (DM / 64) * (NF8 / 64), I_CO = (512 / 64) * (DM / 64), I_AO = (1024 / 64) * (DM / 64), I_WO = (DM / 64) * (DM / 64), I_1 = (DM / 64) * (DFF / 64), I_2 = (DFF / 64) * (DM / 64);
    constexpr int PER_L = I_IN + I_G8 + I_CO + I_AO + I_WO + I_1 + I_2;
    for (int it = gw; it < DEPTH * PER_L; it += NGW) {
        const int l = it / PER_L; int r = it - l * PER_L;
        unsigned char* wl = a.ws + WS_W + (size_t)l * WL_STRIDE;
        if (r < I_IN) { const int nb = NB16 / 64; transpose_item<true>(a.w_in + (size_t)l * DM * INW, INW, (bf16*)(wl + WL_WIN), DM, 0, 64 * (r / nb), 64 * (r % nb), lane, a.norm1 + (size_t)l * DM); continue; } r -= I_IN;
        if (r < I_G8) { const int nb = NF8 / 64; transpose_item_f8<true>(a.w_in + (size_t)l * DM * INW, INW, a.ws + WS_WG8 + (size_t)l * NF8 * DM, DM, 0, 64 * (r / nb), 64 * (r % nb), lane, a.norm1 + (size_t)l * DM, 32.f); continue; } r -= I_G8;
        if (r < I_CO) { const int nb = DM / 64; transpose_item<false>(a.w_conv_out + (size_t)l * 512 * DM, DM, (bf16*)(wl + WL_WCAT), MROW, 512, 64 * (r / nb), 64 * (r % nb), lane); continue; } r -= I_CO;
        if (r < I_AO) { const int nb = DM / 64; transpose_item_f8<false>(a.w_attn_out + (size_t)l * 1024 * DM, DM, wl + WL_WCAT, (size_t)MROW * 2, 2048, 64 * (r / nb), 64 * (r % nb), lane, nullptr, 32.f); continue; } r -= I_AO;
        if (r < I_WO) { const int nb = DM / 64; transpose_item<false>(a.w_o + (size_t)l * DM * DM, DM, (bf16*)(wl + WL_WO), DM, 0, 64 * (r / nb), 64 * (r % nb), lane); continue; } r -= I_WO;
        if (r < I_1) { const int nb = DFF / 64; transpose_item<false>(a.w_ff1 + (size_t)l * DM * DFF, DFF, (bf16*)(wl + WL_W1), DM, 0, 64 * (r / nb), 64 * (r % nb), lane, a.norm2 + (size_t)l * DM); continue; } r -= I_1;
        { const int nb = DM / 64, k0 = 64 * (r / nb), n0 = 64 * (r % nb);
          if (k0 < FF_B16) transpose_item<false>(a.w_ff2 + (size_t)l * DFF * DM, DM, (bf16*)(wl + WL_W2), FROW, 0, k0, n0, lane);
          else transpose_item_f8<false>(a.w_ff2 + (size_t)l * DFF * DM, DM, wl + WL_W2, (size_t)FROW * 2, FF_B16 * 2 - FF_B16, k0, n0, lane, nullptr, 32.f); }
    }
}
__device__ __forceinline__ void fold_pool(const float* pool_w, const float* pool_scale, const float* w_pool_out, unsigned char* ws, int gw, int NGW, int lane) {
    for (int it = gw; it < DEPTH * 4 * 16 * 8; it += NGW) {
        const int dblk = it & 7, cib = (it >> 3) & 15, g = (it >> 7) & 3, l = it >> 9;
        const float* pw = pool_w + ((size_t)(l * 4 + g) * 128 + cib * 8) * 128; const float* ps = pool_scale + (size_t)l * 512 + g * 128;
        const float* wo = w_pool_out + ((size_t)l * 512 + g * 128) * DM + dblk * 256 + lane * 4;
        f32x4 acc[8];
#pragma unroll
        for (int i = 0; i < 8; ++i) acc[i] = (f32x4){0.f, 0.f, 0.f, 0.f};
#pragma unroll 8
        for (int c = 0; c < 128; ++c) { const f32x4 b = *(const f32x4*)(wo + (size_t)c * DM) * ps[c];
#pragma unroll
            for (int i = 0; i < 8; ++i) acc[i] += b * pw[i * 128 + c]; }
        bf16* dst = (bf16*)(ws + WS_W + (size_t)l * WL_STRIDE + WL_WCAT) + (size_t)(dblk * 256 + lane * 4) * MROW + g * 128 + cib * 8;
#pragma unroll
        for (int j = 0; j < 4; ++j) { v4u o; o.x = pk2(acc[0][j], acc[1][j]); o.y = pk2(acc[2][j], acc[3][j]); o.z = pk2(acc[4][j], acc[5][j]); o.w = pk2(acc[6][j], acc[7][j]);
            *(v4u*)(dst + (size_t)j * MROW) = o; }
    }
}

constexpr size_t WS_RSS = WS_WI + 512 * 1024;
__device__ __forceinline__ void xb_row(const float* xrow, bf16* orow, unsigned char* o8row, float* rss, int lane) {
    const f32x4* xr = (const f32x4*)xrow + lane;
    f32x4 v[8]; float s = 0.f;
#pragma unroll
    for (int j = 0; j < 8; ++j) { v[j] = xr[64 * j]; s += (v[j].x * v[j].x + v[j].y * v[j].y) + (v[j].z * v[j].z + v[j].w * v[j].w); }
    s = wave_sum(s, lane);
    v2u* o8 = (v2u*)orow + lane;
#pragma unroll
    for (int j = 0; j < 8; ++j) { v2u w; w.x = pk2(v[j].x, v[j].y); w.y = pk2(v[j].z, v[j].w); o8[64 * j] = w; ((unsigned*)o8row)[lane + 64 * j] = f8x4(v[j].x, v[j].y, v[j].z, v[j].w); }
    if (lane < 8) rss[lane] = (lane == 0) ? s : 0.f;
}

__device__ __forceinline__ void ld8(const bf16* p, float (&f)[8]) { const v4u w = *(const v4u*)p; f[0] = bflo(w.x); f[1] = bfhi(w.x); f[2] = bflo(w.y); f[3] = bfhi(w.y); f[4] = bflo(w.z); f[5] = bfhi(w.z); f[6] = bflo(w.w); f[7] = bfhi(w.w); }
__device__ __forceinline__ void st8(bf16* p, const float (&f)[8]) { v4u w; w.x = pk2(f[0], f[1]); w.y = pk2(f[2], f[3]); w.z = pk2(f[4], f[5]); w.w = pk2(f[6], f[7]); *(v4u*)p = w; }
__device__ __forceinline__ void prep_phase(const bf16* PC, const bf16* Q, const bf16* K, const bf16* V, unsigned char* Q8, unsigned char* K8, unsigned char* VT8, bf16* ACAT, const float* conv_w, const float* q_gain, const float* k_gain, size_t gtid, size_t nthreads) {
    for (size_t idx = gtid; idx < (size_t)SEQ * 64; idx += nthreads) {
        const int g = (int)((idx >> 6) & 3), c8 = g * 16 + (int)(idx & 15), t = (int)(idx >> 8) * 4 + (int)((idx >> 4) & 3);
        float cur[8], sum[8], v[8];
#define POOL_CASE(W) { v4u win[W]; \
            _Pragma("unroll") for (int j = 0; j < W; ++j) win[j] = *(const v4u*)(PC + (size_t)(t - j < 0 ? 0 : t - j) * 2048 + c8 * 8); \
            cur[0] = bflo(win[0].x); cur[1] = bfhi(win[0].x); cur[2] = bflo(win[0].y); cur[3] = bfhi(win[0].y); cur[4] = bflo(win[0].z); cur[5] = bfhi(win[0].z); cur[6] = bflo(win[0].w); cur[7] = bfhi(win[0].w); \
            _Pragma("unroll") for (int e = 0; e < 8; ++e) sum[e] = cur[e]; \
            _Pragma("unroll") for (int j = 1; j < W; ++j) { const float wj = (t - j >= 0) ? 1.f : 0.f; \
                sum[0] += wj * bflo(win[j].x); sum[1] += wj * bfhi(win[j].x); sum[2] += wj * bflo(win[j].y); sum[3] += wj * bfhi(win[j].y); \
                sum[4] += wj * bflo(win[j].z); sum[5] += wj * bfhi(win[j].z); sum[6] += wj * bflo(win[j].w); sum[7] += wj * bfhi(win[j].w); } }
        if (g == 0) POOL_CASE(2) else if (g == 1) POOL_CASE(4) else if (g == 2) POOL_CASE(8) else POOL_CASE(16)
#undef POOL_CASE
        const int w = 2 << g, cnt = (t + 1 < w) ? t + 1 : w; const float inv = 1.0f / (float)cnt;
#pragma unroll
        for (int e = 0; e < 8; ++e) v[e] = sum[e] * inv - cur[e];
        st8(ACAT + (size_t)t * MROW + c8 * 8, v);
    }
    for (size_t idx = gtid; idx < (size_t)SEQ * 64; idx += nthreads) {
        const int t = (int)(idx >> 6), c8 = (int)(idx & 63);
        float y[8], a[8], b[8];
#pragma unroll
        for (int e = 0; e < 8; ++e) y[e] = 0.f;
#pragma unroll
        for (int j = 0; j < 3; ++j) { const int tt = t - 2 + j; if (tt >= 0) { ld8(PC + (size_t)tt * 2048 + 1024 + c8 * 8, a); ld8(PC + (size_t)tt * 2048 + 1536 + c8 * 8, b);
#pragma unroll
                for (int e = 0; e < 8; ++e) y[e] += conv_w[j * 512 + c8 * 8 + e] * (a[e] * b[e]); } }
        ld8(PC + (size_t)t * 2048 + 512 + c8 * 8, a);
#pragma unroll
        for (int e = 0; e < 8; ++e) y[e] *= a[e];
        st8(ACAT + (size_t)t * MROW + 512 + c8 * 8, y);
    }
    { const int ln = (int)(gtid & 63), sg = ln >> 2, dc = ln & 3;
      for (size_t it = gtid >> 6; it < (size_t)(SEQ / 64) * 32; it += nthreads >> 6) {
          const int sblk = (int)(it >> 5), dblk = (int)(it & 31);
          const bf16* src = V + (size_t)(sblk * 64 + sg * 4) * 1024 + dblk * 32 + dc * 8;
          float f0[8], f1[8], f2[8], f3[8]; ld8(src, f0); ld8(src + 1024, f1); ld8(src + 2048, f2); ld8(src + 3072, f3);
          unsigned char* dst = VT8 + (size_t)(dblk * 32 + dc * 8) * SEQ + sblk * 64 + sg * 4;
#pragma unroll
          for (int e = 0; e < 8; ++e) *(unsigned*)(dst + (size_t)e * SEQ) = f8x4(f0[e], f1[e], f2[e], f3[e]); } }
}
__device__ __forceinline__ void score_phase(const bf16* QI, const bf16* KI, const float* WI, float* Sc, LAS unsigned char* lds, int bidx, int G, int tid) {
    const int wave = __builtin_amdgcn_readfirstlane(tid >> 6), lane = tid & 63, c = lane & 31, hi = lane >> 5;
    int par = 0;
#define SC_ITEM(it_, qb_, kc_) int qb_, kc_; { int g_ = 0; while (g_ < 7 && 16 * (g_ + 1) * (g_ + 2) <= (it_)) ++g_; const int r_ = (it_) - 16 * g_ * (g_ + 1), nk_ = g_ + 1; qb_ = g_ * 32 + r_ / nk_; kc_ = r_ % nk_; }
#define SC_STAGE(it_, p_) do { SC_ITEM(it_, qs_, ks_); (void)ks_; _Pragma("unroll") for (int j = 0; j < 4; ++j) { const int hk = wave + 8 * j; \
            __builtin_amdgcn_global_load_lds((const unsigned*)(QI + (size_t)(qs_ * 32 + (lane & 31)) * 512 + hk * 16 + (lane >> 5) * 8), (LAS unsigned*)(lds + (p_) * 32768 + hk * 1024), 16, 0, 0); } \
        if (wave < 4) __builtin_amdgcn_global_load_lds((const unsigned*)(WI + (size_t)qs_ * 256 + wave * 64 + lane), (LAS unsigned*)(lds + 65536 + (p_) * 1024 + wave * 256), 4, 0, 0); } while (0)
    bf16x8 kf[4][4];
#define SC_LDK(it_) do { SC_ITEM(it_, qk_, kk_); const int nad_ = ((qk_ >> 1) + 1) * 64, k0_ = kk_ * 1024 + wave * 128, k0c_ = k0_ < nad_ ? k0_ : 0; \
        _Pragma("unroll") for (int sub = 0; sub < 4; ++sub) _Pragma("unroll") for (int ks = 0; ks < 4; ++ks) kf[sub][ks] = *(const bf16x8*)(KI + (size_t)(k0c_ + sub * 32 + c) * 64 + ks * 16 + hi * 8); } while (0)
    if (bidx < 16 * 8 * 9) { SC_STAGE(bidx, 0); SC_LDK(bidx); }
    for (int it = bidx; it < 16 * 8 * 9; it += G, par ^= 1) {
        SC_ITEM(it, qb, kc); const int nadm = ((qb >> 1) + 1) * 64;
        LAS unsigned char* qbuf = lds + par * 32768;
        const int k0w = kc * 1024 + wave * 128; const bool act = k0w < nadm; const bool more = it + G < 16 * 8 * 9;
        LAS float* wl = (LAS float*)(lds + 65536 + par * 1024);
        asm volatile("s_waitcnt vmcnt(0) lgkmcnt(0)" ::: "memory"); __syncthreads();
        if (more) SC_STAGE(it + G, par ^ 1);
        if (act) {
            const int q = qb * 32 + c;
            f32x16 sacc[4];
#pragma unroll
            for (int sub = 0; sub < 4; ++sub)
#pragma unroll
                for (int r2 = 0; r2 < 16; ++r2) sacc[sub][r2] = 0.f;
#define SC_MMA(D, p, Q) do { _Pragma("unroll") for (int j_ = 0; j_ < 2; ++j_) _Pragma("unroll") for (int r_ = 0; r_ < 16; ++r_) D[j_][r_] = 0.f; \
        _Pragma("unroll") for (int ks_ = 0; ks_ < 4; ++ks_) _Pragma("unroll") for (int j_ = 0; j_ < 2; ++j_) D[j_] = __builtin_amdgcn_mfma_f32_32x32x16_bf16(kf[2 * (p) + j_][ks_], Q[ks_], D[j_], 0, 0, 0); } while (0)
#define SC_ACC(D, p, w) do { _Pragma("unroll") for (int j_ = 0; j_ < 2; ++j_) _Pragma("unroll") for (int r_ = 0; r_ < 16; ++r_) { const float x_ = D[j_][r_]; const int xi_ = __builtin_bit_cast(int, x_); const float t_ = __builtin_bit_cast(float, xi_ > 0 ? xi_ : 0); sacc[2 * (p) + j_][r_] += (w) * t_; } } while (0)
#define SC_MIX() do { _Pragma("unroll") for (int g_ = 0; g_ < 8; ++g_) { __builtin_amdgcn_sched_group_barrier(0x008, 1, 0); __builtin_amdgcn_sched_group_barrier(0x002, 6, 0); } } while (0)
            f32x16 dA[2], dB[2]; bf16x8 qf[4], qn[4];
            constexpr float WSC = 0.35355339059327373f * 0.125f;
            const unsigned qad = (unsigned)(uintptr_t)qbuf + (unsigned)lane * 16u, wad = (unsigned)(uintptr_t)wl + (unsigned)c * 32u;
#define SC_RDQ(dst, ad_) do { asm volatile("ds_read_b128 %0, %1" : "=&v"(dst[0]) : "v"(ad_) : "memory"); asm volatile("ds_read_b128 %0, %1 offset:1024" : "=&v"(dst[1]) : "v"(ad_) : "memory"); \
            asm volatile("ds_read_b128 %0, %1 offset:2048" : "=&v"(dst[2]) : "v"(ad_) : "memory"); asm volatile("ds_read_b128 %0, %1 offset:3072" : "=&v"(dst[3]) : "v"(ad_) : "memory"); } while (0)
#define SC_RDW(dst, ad_) asm volatile("ds_read_b32 %0, %1" : "=&v"(dst) : "v"(ad_) : "memory")
#define SC_LWAIT(q_, w_) asm volatile("s_waitcnt lgkmcnt(0)" : "+v"(q_[0]), "+v"(q_[1]), "+v"(q_[2]), "+v"(q_[3]), "+v"(w_) :: "memory")
            float wcur; SC_RDQ(qf, qad); SC_RDW(wcur, wad); SC_LWAIT(qf, wcur); wcur *= WSC;
            SC_MMA(dA, 0, qf);
            __builtin_amdgcn_sched_barrier(0);
#pragma unroll 1
            for (int h = 0; h < 7; ++h) {
                float wnx; { const unsigned qa_ = qad + (unsigned)(h + 1) * 4096u, wa_ = wad + (unsigned)(h + 1) * 4u; SC_RDQ(qn, qa_); SC_RDW(wnx, wa_); }
                SC_MMA(dB, 1, qf); SC_ACC(dA, 0, wcur); SC_MIX();
                __builtin_amdgcn_sched_barrier(0);
                SC_LWAIT(qn, wnx); wnx *= WSC;
                SC_MMA(dA, 0, qn); SC_ACC(dB, 1, wcur); SC_MIX();
                __builtin_amdgcn_sched_barrier(0);
#pragma unroll
                for (int ks = 0; ks < 4; ++ks) qf[ks] = qn[ks];
                wcur = wnx;
            }
            SC_MMA(dB, 1, qf); SC_ACC(dA, 0, wcur); SC_MIX();
            __builtin_amdgcn_sched_barrier(0);
            if (more) SC_LDK(it + G);
            SC_ACC(dB, 1, wcur);
#undef SC_MMA
#undef SC_ACC
#undef SC_MIX
#undef SC_RDQ
#undef SC_RDW
#undef SC_LWAIT
            { typedef _Float16 h2_t __attribute__((ext_vector_type(2))); typedef short s2_t __attribute__((ext_vector_type(2))); typedef float f2_t __attribute__((ext_vector_type(2)));
#define SC_KEYS(sub_, j_, e2_) __builtin_bit_cast(unsigned, (s2_t)(__builtin_bit_cast(s2_t, __builtin_convertvector((f2_t){sacc[sub_][4 * (j_) + 2 * (e2_)] + 0.0f, sacc[sub_][4 * (j_) + 2 * (e2_) + 1] + 0.0f}, h2_t))))
#define SC_KEY2(sub_, j_, e2_) ({ const s2_t b_ = __builtin_bit_cast(s2_t, SC_KEYS(sub_, j_, e2_)); __builtin_bit_cast(unsigned, (s2_t)(b_ ^ ((b_ >> (short)15) | (s2_t){(short)0x8000, (short)0x8000}))); })
              unsigned short* sp = (unsigned short*)Sc + (size_t)q * SEQ + k0w + 8 * hi;
#pragma unroll
              for (int sub = 0; sub < 4; ++sub)
#pragma unroll
                  for (int jp = 0; jp < 2; ++jp) { const unsigned ax = SC_KEY2(sub, 2 * jp, 0), ay = SC_KEY2(sub, 2 * jp, 1), bx = SC_KEY2(sub, 2 * jp + 1, 0), by = SC_KEY2(sub, 2 * jp + 1, 1);
                      auto r0 = __builtin_amdgcn_permlane32_swap(ax, bx, false, false); auto r1 = __builtin_amdgcn_permlane32_swap(ay, by, false, false);
                      const v4u w = {r0[0], r1[0], r0[1], r1[1]};
                      *(v4u*)(sp + sub * 32 + 16 * jp) = w; }
#undef SC_KEY2
#undef SC_KEYS
            }
        } else if (more) SC_LDK(it + G);
    }
    __syncthreads();
#undef SC_LDK
#undef SC_STAGE
#undef SC_ITEM
}

constexpr int SEL_LDS_PER_WAVE = 2048 * 4 + 128 * 8;
__device__ __forceinline__ void hist_zero(LAS unsigned* hist, int lane) {
#pragma unroll
    for (int j = 0; j < 8; ++j) *(LAS v4u*)(hist + 32 * lane + 4 * j) = (v4u){0u, 0u, 0u, 0u};
    hist[2048 + lane] = 0u;
}
__device__ __forceinline__ void hist_scan(LAS unsigned* hist, unsigned need, int lane, unsigned& bsel, unsigned& above, unsigned& cntb) {
    v4u h[8]; unsigned s = 0u;
#pragma unroll
    for (int j = 0; j < 8; ++j) { h[j] = *(const LAS v4u*)(hist + 32 * lane + 4 * j); s += (h[j].x + h[j].y) + (h[j].z + h[j].w); }
    unsigned S = s;
#pragma unroll
    for (int o = 1; o < 64; o <<= 1) { const unsigned tt = (unsigned)shi((int)S, lane + o); if (lane + o < 64) S += tt; }
    const unsigned long long bal = __ballot(S >= need);
    const int lstar = bal ? 63 - __builtin_clzll(bal) : 0;
    unsigned run = S - s, ab = 0u, cb = 0u; int jb = 0; bool found = false;
#pragma unroll
    for (int j = 31; j >= 0; --j) { const unsigned c = h[j >> 2][j & 3]; if (!found && run + c >= need) { found = true; jb = j; ab = run; cb = c; } run += c; }
    bsel = (unsigned)shi(32 * lane + jb, lstar); above = (unsigned)shi((int)ab, lstar); cntb = (unsigned)shi((int)cb, lstar);
}
#define WLANE2(lo, hi, vlo, vhi, ln) asm("s_nop 4\n\tv_writelane_b32 %0, %2, %4\n\tv_writelane_b32 %1, %3, %4" : "+v"(lo), "+v"(hi) : "s"(vlo), "s"(vhi), "i"(ln))
template <int NG>
__device__ __forceinline__ void select_row_t(const unsigned* Sc, LAS unsigned* hist, int t, int nreg, int lane, unsigned long long& w0, unsigned long long& w1) {
    unsigned u[NG * 8];
    const unsigned short* row = (const unsigned short*)Sc + (size_t)t * SEQ + lane;
#pragma unroll
    for (int i = 0; i < NG * 8; ++i) u[i] = row[i * 64];
    unsigned g0 = 0u, g1 = 0u, g2 = 0u, g3 = 0u;
#pragma unroll
    for (int i = 0; i < NG * 8; ++i) { const unsigned k = (i < nreg) ? u[i] : 0u; u[i] = k;
        if ((i & 3) == 0) g0 = k > g0 ? k : g0; else if ((i & 3) == 1) g1 = k > g1 ? k : g1; else if ((i & 3) == 2) g2 = k > g2 ? k : g2; else g3 = k > g3 ? k : g3;
    }
    unsigned P = g0 < g1 ? g0 : g1; { const unsigned q = g2 < g3 ? g2 : g3; P = P < q ? P : q; }
    unsigned M = g0 > g1 ? g0 : g1; { const unsigned q = g2 > g3 ? g2 : g3; M = M > q ? M : q; }
#pragma unroll
    for (int o = 1; o < 64; o <<= 1) { const unsigned p2 = (unsigned)shi((int)P, lane ^ o), m2 = (unsigned)shi((int)M, lane ^ o); P = P < p2 ? P : p2; M = M > m2 ? M : m2; }
    unsigned base = P, top = M, need = 256u, T, n_eq, need_eq;
    const unsigned span0 = top - base; const int bits0 = span0 ? 32 - __builtin_clz(span0) : 0; int sh = bits0 > 11 ? bits0 - 11 : 0;
    hist_zero(hist, lane);
#pragma unroll
    for (int i0 = 0; i0 < NG * 8; i0 += 8) {
        if (pg8::opq_s(1)) {
#pragma unroll
            for (int i = i0; i < i0 + 8; ++i) { const unsigned bn = (u[i] - base) >> sh, dm = 2048u + (unsigned)lane;
                __hip_atomic_fetch_add(hist + (bn < dm ? bn : dm), 1u, __ATOMIC_RELAXED, __HIP_MEMORY_SCOPE_WAVEFRONT); } } }
    unsigned bsel, above, cnt; hist_scan(hist, need, lane, bsel, above, cnt);
    if (sh == 0) { T = base + bsel; n_eq = cnt; need_eq = need - above; }
    else {
        const unsigned base2 = base + (bsel << sh);
        LAS unsigned* H2 = hist + 64;
        hist_zero(hist, lane);
        const int lo = -1 - lane, hi = 2047;
#pragma unroll
        for (int i0 = 0; i0 < NG * 8; i0 += 8) {
            if (pg8::opq_s(1)) {
#pragma unroll
                for (int i = i0; i < i0 + 8; ++i) { const int d = (int)(u[i] - base2); int ix; asm("v_med3_i32 %0, %1, %2, %3" : "=v"(ix) : "v"(d), "v"(lo), "v"(hi));
                    __hip_atomic_fetch_add(H2 + ix, 1u, __ATOMIC_RELAXED, __HIP_MEMORY_SCOPE_WAVEFRONT); } } }
        hist_scan(H2, 256u, lane, bsel, above, cnt);
        T = base2 + bsel; n_eq = cnt; need_eq = 256u - above;
    }
    int w0l = 0, w0h = 0, w1l = 0, w1h = 0;
    if (n_eq == need_eq) {
#pragma unroll
        for (int i = 0; i < NG * 8; ++i) { const unsigned long long m = __ballot(u[i] >= T);
            const int mlo = (int)(unsigned)m, mhi = (int)(unsigned)(m >> 32);
            if (i < 64) WLANE2(w0l, w0h, mlo, mhi, i & 63); else WLANE2(w1l, w1h, mlo, mhi, i & 63); }
    } else {
        unsigned run = 0u;
#pragma unroll
        for (int i = 0; i < NG * 8; ++i) { const unsigned k = u[i]; const unsigned long long gt = __ballot(k > T), eq = __ballot(k == T);
            unsigned long long m = gt;
            if (eq) {
                const unsigned before = run + (unsigned)__builtin_popcountll(eq & ((1ull << lane) - 1ull));
                m |= __ballot(k == T && before < need_eq); run += (unsigned)__builtin_popcountll(eq); }
            const int mlo = (int)(unsigned)m, mhi = (int)(unsigned)(m >> 32);
            if (i < 64) WLANE2(w0l, w0h, mlo, mhi, i & 63); else WLANE2(w1l, w1h, mlo, mhi, i & 63); }
    }
    w0 = ((unsigned long long)(unsigned)w0h << 32) | (unsigned)w0l; w1 = ((unsigned long long)(unsigned)w1h << 32) | (unsigned)w1l;
}
__device__ __forceinline__ void select_row(const unsigned* Sc, unsigned long long* Mk, LAS unsigned* hist, int t, int lane) {
    const int nreg = t / 64 + 1;
    unsigned long long w0 = (lane < nreg && nreg <= 4) ? ~0ull : 0ull, w1 = 0ull;
    if (nreg > 4) {
        if (nreg <= 16) select_row_t<2>(Sc, hist, t, nreg, lane, w0, w1);
        else if (nreg <= 32) select_row_t<4>(Sc, hist, t, nreg, lane, w0, w1);
        else if (nreg <= 64) select_row_t<8>(Sc, hist, t, nreg, lane, w0, w1);
        else select_row_t<16>(Sc, hist, t, nreg, lane, w0, w1);
    }
    Mk[(size_t)t * 128 + lane] = w0; Mk[(size_t)t * 128 + 64 + lane] = w1;
}

namespace att {
constexpr int D = 128, PQ = 1024, PO = 2048, PM = 128;
constexpr float SCALE = 0.08838834764831845f, THR = 8.f;
constexpr int NW = 8, QBLK = 32, KVBLK = 64, QB = NW * QBLK;
constexpr int SHM_V = KVBLK * D, SHM_K = KVBLK * D;
constexpr int LDS_BYTES = 3 * SHM_V + 2 * SHM_K + NW * 64 * 4;
typedef short s16x4 __attribute__((ext_vector_type(4)));
typedef LAS char* lptr; typedef const LAS char* lcptr; typedef float f32x2v __attribute__((ext_vector_type(2)));
#define KSWZ(row, colB) ((row) * 256 + ((colB) ^ (((row) & 7) << 4)))
#define SBAR() __builtin_amdgcn_sched_barrier(0)
__device__ __forceinline__ int v_st(int k, int c) { const int kk = (k & ~0xC) | ((k & 4) << 1) | ((k & 8) >> 1); return ((kk >> 3) * 4 + (c >> 5)) * 512 + ((kk & 7) * 32 + (c & 31)) * 2; }
__device__ __forceinline__ int v_rd_base(int lane) { return ((lane & 3) << 3) | (((lane >> 2) & 3) << 6) | (((lane >> 4) & 1) << 5) | (((lane >> 5) & 1) << 8); }
constexpr int v_rd_off(int d0, int ks, int half) { return d0 * 512 + ks * 4096 + half * 2048; }
__device__ __forceinline__ int crow(int r, int hi) { return (r & 3) + 8 * (r >> 2) + 4 * hi; }
__device__ __forceinline__ unsigned cvtpk(float lo, float hi) { unsigned r; asm volatile("v_cvt_pk_bf16_f32 %0, %1, %2" : "=v"(r) : "v"(lo), "v"(hi)); return r; }
__device__ __forceinline__ bf16x8 load8(const bf16* p) { return *reinterpret_cast<const bf16x8*>(p); }
__device__ __forceinline__ float mask_and(float p, unsigned bits, int c) { int m; asm("v_bfe_i32 %0, %1, %2, 1" : "=v"(m) : "v"(bits), "i"(c)); return __builtin_bit_cast(float, __builtin_bit_cast(unsigned, p) & (unsigned)m); }
__device__ __forceinline__ void partialSM(f32x16& p0, f32x16& p1, float& m_reg, float& mn, float& alpha, unsigned bits0) {
    float pmax = p0[0];
#pragma unroll
    for (int r = 1; r < 16; ++r) pmax = fmaxf(pmax, p0[r]);
#pragma unroll
    for (int r = 0; r < 16; ++r) pmax = fmaxf(pmax, p1[r]);
    { auto rr = __builtin_amdgcn_permlane32_swap(__float_as_uint(pmax), __float_as_uint(pmax), false, false);
      pmax = fmaxf(__uint_as_float(rr[0]), __uint_as_float(rr[1])); }
    constexpr float C2 = 1.4426950408889634f * SCALE;
    const bool keep = __all((pmax - m_reg) * SCALE <= THR);
    mn = keep ? m_reg : fmaxf(m_reg, pmax); alpha = keep ? 1.f : __builtin_amdgcn_exp2f((m_reg - mn) * C2); m_reg = mn;
    const float mnL = -mn * C2;
#pragma unroll
    for (int r = 0; r < 16; ++r) p0[r] = fmaf(p0[r], C2, mnL);
#pragma unroll
    for (int r = 0; r < 16; ++r) p1[r] = fmaf(p1[r], C2, mnL);
#pragma unroll
    for (int r = 0; r < 16; ++r) p0[r] = mask_and(__builtin_amdgcn_exp2f(p0[r]), bits0, (r & 3) + 8 * (r >> 2));
}
__device__ __forceinline__ void finishSM(f32x16& p0, f32x16& p1, float alpha, float& l_reg, bf16x8& pa0, bf16x8& pa1, bf16x8& pa2, bf16x8& pa3, unsigned bits1) {
#pragma unroll
    for (int r = 0; r < 16; ++r) p1[r] = mask_and(__builtin_amdgcn_exp2f(p1[r]), bits1, (r & 3) + 8 * (r >> 2));
    float ps = 0;
#pragma unroll
    for (int r = 0; r < 16; ++r) ps += p0[r];
#pragma unroll
    for (int r = 0; r < 16; ++r) ps += p1[r];
    { auto rr = __builtin_amdgcn_permlane32_swap(__float_as_uint(ps), __float_as_uint(ps), false, false);
      ps = __uint_as_float(rr[0]) + __uint_as_float(rr[1]); }
    l_reg = l_reg * alpha + ps;
#define PK4(P, B_, OUT) do { unsigned a0 = cvtpk(P[B_+0], P[B_+1]), a1 = cvtpk(P[B_+2], P[B_+3]);                          \
        unsigned b0 = cvtpk(P[B_+4], P[B_+5]), b1 = cvtpk(P[B_+6], P[B_+7]);                                             \
        auto r0 = __builtin_amdgcn_permlane32_swap(a0, b0, false, false); auto r1 = __builtin_amdgcn_permlane32_swap(a1, b1, false, false); \
        v4u w = {r0[0], r1[0], r0[1], r1[1]}; OUT = __builtin_bit_cast(bf16x8, w); } while (0)
    PK4(p0, 0, pa0); PK4(p0, 8, pa1); PK4(p1, 0, pa2); PK4(p1, 8, pa3);
#undef PK4
}
template <int KB>
__device__ __forceinline__ void qkt(f32x16& p0, f32x16& p1, lcptr K_lds, int r32, int hi, const bf16x8* qr) {
#pragma unroll
    for (int r = 0; r < 16; ++r) { p0[r] = 0.f; p1[r] = 0.f; }
    lcptr kb[4];
#pragma unroll
    for (int dd = 0; dd < 4; ++dd) kb[dd] = K_lds + KB * SHM_K + KSWZ(r32, (dd * 16 + hi * 8) * 2);
#pragma unroll
    for (int d0 = 0; d0 < 8; ++d0) { lcptr a = kb[d0 & 3] + (d0 >> 2) * 128;
        bf16x8 b0 = *(const LAS bf16x8*)(a);
        bf16x8 b1 = *(const LAS bf16x8*)(a + 32 * 256);
        p0 = __builtin_amdgcn_mfma_f32_32x32x16_bf16(b0, qr[d0], p0, 0, 0, 0);
        p1 = __builtin_amdgcn_mfma_f32_32x32x16_bf16(b1, qr[d0], p1, 0, 0, 0); }
}
typedef int v8i __attribute__((ext_vector_type(8))); typedef int v4i __attribute__((ext_vector_type(4)));
template <int KB>
__device__ __forceinline__ void qkt8(f32x16& p0, f32x16& p1, const int (&kq)[4], const v8i* qf) {
#pragma unroll
    for (int r = 0; r < 16; ++r) { p0[r] = 0.f; p1[r] = 0.f; }
#define KRD8(i, j) (*(const LAS v4i*)(unsigned)(kq[i] + KB * SHM_K + (j) * 32 * 128))
#pragma unroll
    for (int m = 0; m < 2; ++m) {
        const v8i a0 = __builtin_shufflevector(KRD8(2 * m, 0), KRD8(2 * m + 1, 0), 0, 1, 2, 3, 4, 5, 6, 7);
        const v8i a1 = __builtin_shufflevector(KRD8(2 * m, 1), KRD8(2 * m + 1, 1), 0, 1, 2, 3, 4, 5, 6, 7);
        p0 = __builtin_amdgcn_mfma_scale_f32_32x32x64_f8f6f4(a0, qf[m], p0, 0, 0, 0, 0x7f7f7f7f, 0, 0x7f7f7f7f);
        p1 = __builtin_amdgcn_mfma_scale_f32_32x32x64_f8f6f4(a1, qf[m], p1, 0, 0, 0, 0x7f7f7f7f, 0, 0x7f7f7f7f); }
#undef KRD8
}
__device__ __forceinline__ void pv_tile(f32x16* o, int vb0, bf16x8 pa0, bf16x8 pa1, bf16x8 pa2, bf16x8 pa3) {
#define TRRD(dst, off) asm volatile("ds_read_b64_tr_b16 %0, %1 offset:%2" : "=&v"(dst) : "v"(vb0), "i"(off) : "memory")
#define PV_D0(d0) do { s16x4 l0, l1, l2, l3, h0, h1, h2, h3; constexpr int b_ = v_rd_off(d0, 0, 0); \
        TRRD(l0, b_); TRRD(h0, b_ + 2048); TRRD(l1, b_ + 4096); TRRD(h1, b_ + 6144); TRRD(l2, b_ + 8192); TRRD(h2, b_ + 10240); TRRD(l3, b_ + 12288); TRRD(h3, b_ + 14336); \
        asm volatile("s_waitcnt lgkmcnt(0)" : "+v"(l0), "+v"(h0), "+v"(l1), "+v"(h1), "+v"(l2), "+v"(h2), "+v"(l3), "+v"(h3) :: "memory"); \
        o[d0] = __builtin_amdgcn_mfma_f32_32x32x16_bf16(pa0, (bf16x8){l0[0], l0[1], l0[2], l0[3], h0[0], h0[1], h0[2], h0[3]}, o[d0], 0, 0, 0);   \
        o[d0] = __builtin_amdgcn_mfma_f32_32x32x16_bf16(pa1, (bf16x8){l1[0], l1[1], l1[2], l1[3], h1[0], h1[1], h1[2], h1[3]}, o[d0], 0, 0, 0);   \
        o[d0] = __builtin_amdgcn_mfma_f32_32x32x16_bf16(pa2, (bf16x8){l2[0], l2[1], l2[2], l2[3], h2[0], h2[1], h2[2], h2[3]}, o[d0], 0, 0, 0);   \
        o[d0] = __builtin_amdgcn_mfma_f32_32x32x16_bf16(pa3, (bf16x8){l3[0], l3[1], l3[2], l3[3], h3[0], h3[1], h3[2], h3[3]}, o[d0], 0, 0, 0); } while (0)
    PV_D0(0); PV_D0(1); PV_D0(2); PV_D0(3);
#undef PV_D0
#undef TRRD
}
__device__ __forceinline__ unsigned cvt4_e4m3(float a, float b, float c, float d) { int w = 0; w = __builtin_amdgcn_cvt_pk_fp8_f32(a, b, w, false); w = __builtin_amdgcn_cvt_pk_fp8_f32(c, d, w, true); return (unsigned)w; }
__device__ __forceinline__ void finishSM8(f32x16& p0, f32x16& p1, float alpha, float& l_reg, v8i& pA, unsigned bits1) {
#pragma unroll
    for (int r = 0; r < 16; ++r) p1[r] = mask_and(__builtin_amdgcn_exp2f(p1[r]), bits1, (r & 3) + 8 * (r >> 2));
    float ps = 0;
#pragma unroll
    for (int r = 0; r < 16; ++r) ps += p0[r];
#pragma unroll
    for (int r = 0; r < 16; ++r) ps += p1[r];
    { auto rr = __builtin_amdgcn_permlane32_swap(__float_as_uint(ps), __float_as_uint(ps), false, false);
      ps = __uint_as_float(rr[0]) + __uint_as_float(rr[1]); }
    l_reg = l_reg * alpha + ps;
#pragma unroll
    for (int i = 0; i < 4; ++i) { const unsigned x = cvt4_e4m3(p0[4 * i], p0[4 * i + 1], p0[4 * i + 2], p0[4 * i + 3]), y = cvt4_e4m3(p1[4 * i], p1[4 * i + 1], p1[4 * i + 2], p1[4 * i + 3]);
        auto rr = __builtin_amdgcn_permlane32_swap(x, y, false, false); pA[2 * i] = (int)rr[0]; pA[2 * i + 1] = (int)rr[1]; }
}
#define VRD(dst, addr, off) asm volatile("ds_read_b128 %0, %1 offset:%2" : "=&v"(dst) : "v"(addr), "i"(off) : "memory")
#define PV_RD(d0) v4i l##d0, h##d0; VRD(l##d0, vb0, d0 * 2048); VRD(h##d0, vb1, d0 * 2048);
#define PV_WT(d0, n) asm volatile("s_waitcnt lgkmcnt(%2)" : "+v"(l##d0), "+v"(h##d0) : "i"(n) : "memory")
#define PV_MM(d0) o[d0] = __builtin_amdgcn_mfma_scale_f32_32x32x64_f8f6f4(pA, __builtin_shufflevector(l##d0, h##d0, 0, 1, 2, 3, 4, 5, 6, 7), o[d0], 0, 0, 0, 0x7f7f7f7f, 0, 0x7f7f7f7f);
__device__ __forceinline__ void pv_tile8(f32x16* o, int vb0, int vb1, v8i pA) {
    PV_RD(0) PV_RD(1) PV_WT(0, 2); PV_MM(0) PV_RD(2) PV_WT(1, 2); PV_MM(1) PV_RD(3) PV_WT(2, 2); PV_MM(2) PV_WT(3, 0); PV_MM(3)
}
__device__ __forceinline__ void pv_sm8(f32x16* o, int vb0, int vb1, v8i pA, f32x16& p0, f32x16& p1, float& m_reg, float& mn, float& alpha, unsigned bits0) {
#define PV_END() do { __builtin_amdgcn_sched_group_barrier(0x008, 1, 0); SBAR(); } while (0)
    constexpr float C2 = 1.4426950408889634f * SCALE;
    PV_RD(0) PV_RD(1) PV_WT(0, 2); PV_MM(0)
    float pmax = p0[0];
#pragma unroll
    for (int r = 1; r < 16; ++r) pmax = fmaxf(pmax, p0[r]);
#pragma unroll
    for (int r = 0; r < 16; ++r) pmax = fmaxf(pmax, p1[r]);
    { auto rr = __builtin_amdgcn_permlane32_swap(__float_as_uint(pmax), __float_as_uint(pmax), false, false);
      pmax = fmaxf(__uint_as_float(rr[0]), __uint_as_float(rr[1])); }
    const bool keep = __all((pmax - m_reg) * SCALE <= THR);
    mn = keep ? m_reg : fmaxf(m_reg, pmax); alpha = keep ? 1.f : __builtin_amdgcn_exp2f((m_reg - mn) * C2); m_reg = mn;
    float mnL = -mn * C2;
    asm volatile("" : "+v"(mnL));
    PV_END();
    PV_RD(2) PV_WT(1, 2); PV_MM(1)
#pragma unroll
    for (int r = 0; r < 16; ++r) p0[r] = fmaf(p0[r], C2, mnL);
#pragma unroll
    for (int r = 0; r < 16; ++r) p1[r] = fmaf(p1[r], C2, mnL);
    asm volatile("" : "+v"(p0), "+v"(p1));
    PV_END();
    PV_RD(3) PV_WT(2, 2); PV_MM(2)
#pragma unroll
    for (int r = 0; r < 8; ++r) p0[r] = mask_and(__builtin_amdgcn_exp2f(p0[r]), bits0, (r & 3) + 8 * (r >> 2));
    asm volatile("" : "+v"(p0));
    PV_END();
    PV_WT(3, 0); PV_MM(3)
#pragma unroll
    for (int r = 8; r < 16; ++r) p0[r] = mask_and(__builtin_amdgcn_exp2f(p0[r]), bits0, (r & 3) + 8 * (r >> 2));
    asm volatile("" : "+v"(p0));
    PV_END();
#undef PV_END
}
#undef PV_RD
#undef PV_WT
#undef PV_MM
#undef VRD
struct BlockRef { const unsigned char* Q; const unsigned char* K; const unsigned char* V; bf16* OP; float* ML; const unsigned long long* M; int nt; };
struct Seam { v8i qf[2]; v2u mkA, mkB; int vs0; };
#define VMW() __builtin_amdgcn_s_waitcnt(0x0F70)
#define DMA_K(Kp, k0, bf) do { const char* kb_ = (const char*)((Kp) + (size_t)(k0) * 1024) + ksrc;                                                  \
        __builtin_amdgcn_global_load_lds((const unsigned*)kb_, (LAS unsigned*)(K_lds + (bf) * SHM_K + wid * 1024), 16, 0, 0); } while (0)
#define DMA_V(Vp, k0, slot) do { const char* vb_ = (const char*)(Vp) + (k0) + vsrc;                                                                \
        __builtin_amdgcn_global_load_lds((const unsigned*)vb_, (LAS unsigned*)(V_lds + (slot) * SHM_V + wid * 1024), 16, 0, 0); } while (0)
#define DMA_SRC() const unsigned ksrc = (unsigned)((wid * 8 + (lane >> 3)) * 1024 + (((lane & 7) ^ ((lane >> 3) & 7)) << 4));     \
        const unsigned vsrc = (unsigned)((wid * 16 + (lane >> 2)) * SEQ + (((lane & 3) ^ ((lane >> 3) & 3)) << 4))
#define MLOAD(ref, t) (*(const v2u*)((const char*)((ref).M + (t)) + (unsigned)((wid * QBLK + r32) * (PM * 8))))
__device__ __forceinline__ void prime(const BlockRef& cur, lptr lds, Seam& S, const int tid) {
    const int wid = __builtin_amdgcn_readfirstlane(tid >> 6), lane = tid & 63, r32 = lane & 31, hi = lane >> 5;
    lptr V_lds = lds; lptr K_lds = lds + 3 * SHM_V; DMA_SRC();
    { const unsigned qoff = (unsigned)((wid * QBLK + r32) * 1024 + hi * 32);
#pragma unroll
      for (int m = 0; m < 2; ++m) S.qf[m] = __builtin_shufflevector(*(const v4i*)(cur.Q + qoff + m * 64), *(const v4i*)(cur.Q + qoff + m * 64 + 16), 0, 1, 2, 3, 4, 5, 6, 7); }
    S.mkA = MLOAD(cur, 0); S.vs0 = 0;
    DMA_K(cur.K, 0, 0); DMA_V(cur.V, 0, 0); DMA_K(cur.K, KVBLK, 1); DMA_V(cur.V, KVBLK, 1); VMW();
    __syncthreads();
}
__device__ __forceinline__ void block(const BlockRef& cur, const BlockRef& nxt, lptr lds, Seam& S, const int tid) {
    const int wid = __builtin_amdgcn_readfirstlane(tid >> 6), lane = tid & 63, r32 = lane & 31, hi = lane >> 5;
    const int NT = cur.nt;
    lptr V_lds = lds; lptr K_lds = lds + 3 * SHM_V; DMA_SRC();
    LAS float* wsf = (LAS float*)(lds + 3 * SHM_V + 2 * SHM_K) + wid * 64; LAS float* al_l = wsf + 32;
    float m_reg = -1e30f, l_reg = 0; f32x16 o[4];
#pragma unroll
    for (int d = 0; d < 4; ++d)
#pragma unroll
        for (int r = 0; r < 16; ++r) o[d][r] = 0.f;
    const int vb0 = (int)(unsigned)(uintptr_t)V_lds + r32 * 64 + (((hi * 2) ^ ((r32 >> 1) & 3)) << 4);
    const unsigned char* Kh = cur.K; const unsigned char* Vh = cur.V;
    const int sh = 4 * hi;
    int kq[4];
#pragma unroll
    for (int i = 0; i < 4; ++i) { kq[i] = (int)(unsigned)(uintptr_t)K_lds + r32 * 128 + ((((hi * 2 + 4 * (i >> 1)) + (i & 1)) ^ (r32 & 7)) << 4); asm volatile("" : "+v"(kq[i])); }
    int va = S.vs0, vb = va == 2 ? 0 : va + 1, vc = vb == 2 ? 0 : vb + 1;
#define RESC(a) do { if (__any((a) < 1.f)) { if (hi == 0) al_l[r32] = (a); asm volatile("s_waitcnt lgkmcnt(0)" ::: "memory");              \
                     for (int d_ = 0; d_ < 4; ++d_) for (int r = 0; r < 16; ++r) o[d_][r] *= al_l[crow(r, hi)]; } } while (0)
#define KBASE(t) ((t) * KVBLK)
    f32x16 pA0, pA1, pB0, pB1; float mnA, mnB, alA, alB; v8i pP;
    S.mkB = MLOAD(cur, 1);
    SBAR(); qkt8<0>(pA0, pA1, kq, S.qf);
    partialSM(pA0, pA1, m_reg, mnA, alA, S.mkA.x >> sh);
    VMW(); __syncthreads();
#define HALF_STEP(PX0, PX1, mnX, alX, mkX, PY0, PY1, alY, mkY, t, KB, SB) do {                                                \
        SBAR(); qkt8<KB>(PX0, PX1, kq, S.qf);                                                                                 \
        finishSM8(PY0, PY1, alY, l_reg, pP, mkY.y >> sh); SBAR();                                                             \
        DMA_K(Kh, KBASE((t) + 1), SB); DMA_V(Vh, KBASE((t) + 1), vc); mkY = MLOAD(cur, (t) + 1);                              \
        { int vbs_ = vb0 + va * SHM_V; unsigned bts_ = mkX.x >> sh; asm volatile("" : "+v"(vbs_), "+v"(bts_)); SBAR();        \
          pv_sm8(o, vbs_, vbs_ ^ 16, pP, PX0, PX1, m_reg, mnX, alX, bts_); }                                                  \
        RESC(alX); VMW(); __syncthreads();                                                                                    \
        { const int t_ = va; va = vb; vb = vc; vc = t_; } } while (0)
    for (int t = 1; t + 1 < NT; t += 2) {
        HALF_STEP(pB0, pB1, mnB, alB, S.mkB, pA0, pA1, alA, S.mkA, t, 1, 0);
        HALF_STEP(pA0, pA1, mnA, alA, S.mkA, pB0, pB1, alB, S.mkB, t + 1, 0, 1);
    }
    SBAR(); qkt8<1>(pB0, pB1, kq, S.qf);
    finishSM8(pA0, pA1, alA, l_reg, pP, S.mkA.y >> sh); SBAR();
    DMA_K(nxt.K, 0, 0); DMA_V(nxt.V, 0, vc); SBAR();
    { const int ln_ = pg8::opq_v(lane); const unsigned qoff = (unsigned)((wid * QBLK + (ln_ & 31)) * 1024 + (ln_ >> 5) * 32);
#pragma unroll
      for (int m = 0; m < 2; ++m) S.qf[m] = __builtin_shufflevector(*(const v4i*)(nxt.Q + qoff + m * 64), *(const v4i*)(nxt.Q + qoff + m * 64 + 16), 0, 1, 2, 3, 4, 5, 6, 7); }
    S.mkA = MLOAD(nxt, 0);
    { int vbs_ = vb0 + va * SHM_V; unsigned bts_ = S.mkB.x >> sh; asm volatile("" : "+v"(vbs_), "+v"(bts_)); SBAR();
      pv_sm8(o, vbs_, vbs_ ^ 16, pP, pB0, pB1, m_reg, mnB, alB, bts_); }
    RESC(alB); VMW(); __syncthreads();
    DMA_K(nxt.K, KVBLK, 1); DMA_V(nxt.V, KVBLK, va); SBAR();
    finishSM8(pB0, pB1, alB, l_reg, pP, S.mkB.y >> sh); SBAR(); pv_tile8(o, vb0 + vb * SHM_V, (vb0 + vb * SHM_V) ^ 16, pP);
    SBAR(); VMW(); SBAR();
    S.vs0 = vc;
    { const int ln_ = pg8::opq_v(lane), r32e = ln_ & 31, hie = ln_ >> 5;
      if (hie == 0) { *(f32x2v*)((char*)cur.ML + (unsigned)((wid * QBLK + r32e) * 8)) = (f32x2v){m_reg, l_reg}; }
      lptr ot = lds + 49152 + wid * 8704;
#pragma unroll
      for (int r = 0; r < 16; ++r)
#pragma unroll
          for (int d0 = 0; d0 < 4; ++d0) *(LAS bf16*)(ot + ((r & 3) + 8 * (r >> 2) + 4 * hie) * 272 + (d0 * 32 + r32e) * 2) = (bf16)f2bf(o[d0][r]);
      asm volatile("s_waitcnt lgkmcnt(0)" ::: "memory");
      char* Ow = (char*)cur.OP + (unsigned)(wid * QBLK * D * 2);
#pragma unroll
      for (int i2 = 0; i2 < 8; ++i2) { const int p = i2 * 64 + ln_, row = p >> 4, pc = p & 15;
          *(v4u*)(Ow + row * 256 + pc * 16) = *(const LAS v4u*)(ot + row * 272 + pc * 16); } }
    __builtin_amdgcn_s_barrier();
#undef RESC
#undef KBASE
#undef HALF_STEP
}
#undef DMA_K
#undef DMA_V
#undef DMA_SRC
#undef VMW
#undef MLOAD
#undef KSWZ
#undef SBAR
}

#define XB_TMO      128
#define XB_XCNT(j)  (256  + 64 * (j))
#define XB_XSUB(j)  (1280 + 64 * (j))
#define XB_XGEN(j)  (2304 + 64 * (j))
#define XB_TOP      3328
#define XB_TOPGEN   3392
#define XCD_BAR_WORDS 3456
#define XB_SPIN_CAP (1u << 18)
typedef __attribute__((address_space(1))) unsigned gu32;
__device__ __forceinline__ unsigned xb_ld(unsigned* p)              { return __hip_atomic_load((gu32*)p, __ATOMIC_RELAXED, __HIP_MEMORY_SCOPE_AGENT); }
__device__ __forceinline__ unsigned xb_add(unsigned* p, unsigned v) { return __hip_atomic_fetch_add((gu32*)p, v, __ATOMIC_RELAXED, __HIP_MEMORY_SCOPE_AGENT); }
__device__ __forceinline__ unsigned xb_xcc_id() { return (unsigned)__builtin_amdgcn_s_getreg((3 << 11) | 20) & 0xFu; }
#define XB_SPIN(cond, bar) do { unsigned _sp = 0; while (cond) { __builtin_amdgcn_s_sleep(1); \
    if ((++_sp & 255u) == 0u) { if (xb_ld(&(bar)[XB_TMO])) break; if (_sp > XB_SPIN_CAP) { (void)xb_add(&(bar)[XB_TMO], 1u); break; } } } } while (0)
struct XcdBarrier { unsigned* bar; unsigned x; volatile LAS unsigned* st; unsigned w0; };
__device__ __forceinline__ bool xb_thread0(unsigned w0) { return w0 != 0u && pg8::lane_now() == 0; }
__device__ __forceinline__ XcdBarrier xcd_barrier_post(unsigned* bar, volatile LAS unsigned* st, unsigned w0) {
    XcdBarrier b; b.bar = bar; b.x = xb_xcc_id(); b.st = st; b.w0 = w0;
    if (xb_thread0(w0)) (void)xb_add(&bar[XB_XCNT(b.x)], 1u);
    return b;
}
__device__ __forceinline__ void xcd_barrier_complete(unsigned* bar, unsigned x, unsigned& nloc, unsigned& nx) {
    const unsigned G = gridDim.x * gridDim.y * gridDim.z;
    unsigned sum, cnt, mine, sp = 0u;
    for (;;) {
        sum = 0u; cnt = 0u; mine = 0u;
#pragma unroll
        for (unsigned j = 0; j < 16; ++j) { const unsigned c = xb_ld(&bar[XB_XCNT(j)]); sum += c; cnt += (c > 0u) ? 1u : 0u; mine = (j == x) ? c : mine; }
        if (sum == G) break;
        __builtin_amdgcn_s_sleep(1);
        if ((++sp & 255u) == 0u) { if (xb_ld(&bar[XB_TMO])) break; if (sp > XB_SPIN_CAP) { (void)xb_add(&bar[XB_TMO], 1u); break; } }
    }
    nloc = mine > 0u ? mine : 1u; nx = cnt > 0u ? cnt : 1u;
}
__device__ __forceinline__ void xcd_barrier(const XcdBarrier& b) {
    asm volatile("s_waitcnt vmcnt(0)" ::: "memory");
    __syncthreads();
    if (xb_thread0(b.w0)) {
        unsigned* bar = b.bar; unsigned bx = b.x;
        asm volatile("" : "+s"(bar), "+s"(bx)); bar = (unsigned*)(__attribute__((address_space(1))) unsigned*)bar;
        __builtin_amdgcn_s_waitcnt(0);
        unsigned nloc = b.st[0], nx = b.st[1];
        if (nloc == 0u) { xcd_barrier_complete(bar, bx, nloc, nx); b.st[0] = nloc; b.st[1] = nx; }
        const unsigned old = xb_add(&bar[XB_XSUB(bx)], 1u);
        const unsigned gen = old / nloc;
        if (old + 1u == (gen + 1u) * nloc) {
            __builtin_amdgcn_fence(__ATOMIC_RELEASE, "agent");
            asm volatile("s_waitcnt vmcnt(0)" ::: "memory");
            const unsigned og = xb_add(&bar[XB_TOP], 1u);
            const unsigned tg = og / nx;
            if (og + 1u == (tg + 1u) * nx) xb_add(&bar[XB_TOPGEN], 1u);
            else XB_SPIN(xb_ld(&bar[XB_TOPGEN]) == tg, bar);
            __builtin_amdgcn_fence(__ATOMIC_ACQUIRE, "agent");
            xb_add(&bar[XB_XGEN(bx)], 1u);
            asm volatile("s_waitcnt vmcnt(0)" ::: "memory");
        } else {
            XB_SPIN(xb_ld(&bar[XB_XGEN(bx)]) == gen, bar);
            __builtin_amdgcn_fence(__ATOMIC_ACQUIRE, "agent");
            asm volatile("s_waitcnt vmcnt(0)" ::: "memory");
        }
    }
    __syncthreads();
}

#ifndef RP_PRO
#define RP_PRO 1
#endif
#ifndef RP_ATT
#define RP_ATT 1
#endif
#ifndef RP_IDX
#define RP_IDX 1
#endif
#ifndef RP_SEL
#define RP_SEL 1
#endif
#ifndef RP_SEL2
#define RP_SEL2 1
#endif
#ifndef RP_MRG2
#define RP_MRG2 1
#endif
#ifndef RP_SC2
#define RP_SC2 1
#endif
#ifndef RP_INP
#define RP_INP 1
#endif
#ifndef RP_MRG
#define RP_MRG 1
#endif
#ifndef RP_FF1
#define RP_FF1 1
#endif
#ifndef RP_NRM
#define RP_NRM 1
#endif
constexpr int NWAVES = 8;
constexpr int RING_BYTES = 131072;
constexpr int LDSCTL_OFF = RING_BYTES;
constexpr int LDS_BYTES = 147456;
constexpr int CW_BAR = 4096;
struct MegaArgs { const float* in[15]; float* out; unsigned char* ws; };

template <class T> __device__ __forceinline__ T* asg(T* p) { return (T*)(__attribute__((address_space(1))) T*)p; }
typedef const __attribute__((address_space(4))) MegaArgs* KArgP;
__device__ __forceinline__ KArgP kargs() { KArgP q = (KArgP)__builtin_amdgcn_kernarg_segment_ptr(); asm volatile("" : "+s"(q)); return q; }

__global__ void __launch_bounds__(NWAVES * 64, 2) mega_fwd(MegaArgs a_unused) {
    extern __shared__ __attribute__((aligned(1024))) unsigned char lds_raw[];
    LAS unsigned char* lds = (LAS unsigned char*)lds_raw;
    const int tid = threadIdx.x, lane = tid & 63, wave = __builtin_amdgcn_readfirstlane(tid >> 6);
    const int G = gridDim.x, gw = blockIdx.x * NWAVES + wave, NGW = G * NWAVES;
    for (int u = tid; u < (LDS_BYTES - LDSCTL_OFF) / 4; u += NWAVES * 64) ((LAS unsigned*)(lds + LDSCTL_OFF))[u] = 0u;
    __syncthreads();
    XcdBarrier bar = xcd_barrier_post((unsigned*)(asg(kargs()->ws) + WS_CTL) + CW_BAR, (volatile LAS unsigned*)(lds + LDSCTL_OFF) + 8, wave == 0 ? 1u : 0u);
#define LANE pg8::lane_now()
#define TID (pg8::opq_s(wave) * 64 + pg8::lane_now())
#define GTID ((size_t)pg8::opq_s((int)blockIdx.x) * (NWAVES * 64) + (size_t)TID)
#define GW pg8::opq_s(gw)
#define BIDX pg8::opq_s((int)blockIdx.x)
#define NTHR ((size_t)gridDim.x * (NWAVES * 64))

    for (int rp = 0; rp < RP_PRO; ++rp) {
    { KArgP q = kargs(); ConvArgs ca{asg(q->in[2]), asg(q->in[9]), asg(q->in[10]), asg(q->in[11]), asg(q->in[13]), asg(q->in[14]), asg(q->in[1]), asg(q->in[12]), asg(q->ws)};
      convert_weights(ca, GW, NGW, LANE); }
    { KArgP q = kargs(); fold_pool(asg(q->in[3]), asg(q->in[4]), asg(q->in[8]), asg(q->ws), GW, NGW, LANE); }
    { KArgP q = kargs(); unsigned char* ws = asg(q->ws); const float* x = asg(q->in[0]); const int ln = LANE;
      for (int m = GW; m < SEQ; m += NGW) xb_row(x + (size_t)m * DM, (bf16*)(ws + WS_HB) + (size_t)m * DM, ws + WS_X8 + (size_t)m * DM, (float*)(ws + WS_RSS) + (size_t)m * 8, ln); }
    xcd_barrier(bar); }

#pragma unroll 1
    for (int l = 0; l < DEPTH; ++l) {
        for (int rp = 0; rp < RP_INP; ++rp) {
        { KArgP q = kargs(); unsigned char* ws = asg(q->ws); unsigned char* wl = ws + WS_W + (size_t)l * WL_STRIDE;
          pg8::Gemm g{(const bf16*)(ws + WS_HB), (const bf16*)(wl + WL_WIN), SEQ, NB16, DM, DM, DM, 0}; pg8::StaticOrder S; S.init(SEQ, NB16, G, BIDX);
          EpiInProj E{(bf16*)(ws + WS_PC), (bf16*)(ws + WS_Q), (bf16*)(ws + WS_K), (bf16*)(ws + WS_V), (bf16*)(ws + WS_QI), (bf16*)(ws + WS_KI), (bf16*)(ws + WS_G), (float*)(ws + WS_WI), (const float*)(ws + WS_RSS), (LAS float*)(lds + RING_BYTES + 8192)};
          pg8::gemm_phase<EpiInProj, pg8::StaticOrder, true, true>(lds, g, S, E, TID); }
        { KArgP q = kargs(); unsigned char* ws = asg(q->ws);
          pg8::Gemm g{(const bf16*)(ws + WS_X8), (const bf16*)(ws + WS_WG8 + (size_t)l * NF8 * DM), SEQ, NF8, DM / 2, DM / 2, DM / 2, 0}; pg8::StaticOrder S; S.init(SEQ, NF8, G, G - 1 - BIDX);
          EpiGate E{(bf16*)(ws + WS_Q), (bf16*)(ws + WS_K), (bf16*)(ws + WS_V), (bf16*)(ws + WS_G), (const float*)(ws + WS_RSS), (LAS float*)(lds + RING_BYTES + 9216), ws + WS_X, asg(q->in[6]) + (size_t)l * 128, asg(q->in[7]) + (size_t)l * 128, (LAS float*)(lds + RING_BYTES + 256)};
          pg8::gemm_phase<EpiGate, pg8::StaticOrder, true, true, true>(lds, g, S, E, TID); }
        xcd_barrier(bar); }
        for (int rp = 0; rp < RP_IDX; ++rp) {
        { KArgP q = kargs(); unsigned char* ws = asg(q->ws);
          prep_phase((const bf16*)(ws + WS_PC), (const bf16*)(ws + WS_Q), (const bf16*)(ws + WS_K), (const bf16*)(ws + WS_V), ws + WS_X, ws + WS_X + 8 * MiB, ws + WS_X + 16 * MiB, (bf16*)(ws + WS_ACAT), asg(q->in[5]) + (size_t)l * 3 * 512, asg(q->in[6]) + (size_t)l * 128, asg(q->in[7]) + (size_t)l * 128, GTID, NTHR); }
        { KArgP q = kargs(); unsigned char* ws = asg(q->ws);
          score_phase((const bf16*)(ws + WS_QI), (const bf16*)(ws + WS_KI), (const float*)(ws + WS_WI), (float*)(ws + WS_S), lds, BIDX, G, TID);
          if (RP_SC2 > 1) score_phase((const bf16*)(ws + WS_QI), (const bf16*)(ws + WS_KI), (const float*)(ws + WS_WI), (float*)(ws + WS_S), lds, BIDX, G, TID); }
        xcd_barrier(bar); }
        for (int rp = 0; rp < RP_SEL; ++rp) {
        { KArgP q = kargs(); unsigned char* ws = asg(q->ws); const unsigned* SC = (const unsigned*)(ws + WS_S); unsigned long long* MK = (unsigned long long*)(ws + WS_MASK);
          LAS unsigned* hist = (LAS unsigned*)(lds + wave * SEL_LDS_PER_WAVE);
          const int ln = LANE; int k = 0;
          for (int i0 = GW; i0 < SEQ * RP_SEL2; i0 += NGW, ++k) { const int i = i0 & (SEQ - 1); const int t = ((i ^ k) & 1) ? (SEQ - 1 - (i >> 1)) : (i >> 1); select_row(SC, MK, hist, t, ln); } }
        xcd_barrier(bar); }
        for (int rp = 0; rp < RP_ATT; ++rp) {
        { KArgP q = kargs(); unsigned char* ws = asg(q->ws);
          const unsigned char* Q8b = ws + WS_X; const unsigned char* K8b = ws + WS_X + 8 * MiB; const unsigned char* V8b = ws + WS_X + 16 * MiB; const unsigned long long* Mb = (const unsigned long long*)(ws + WS_MASK);
          bf16* OPb = (bf16*)(ws + WS_MF); float* MLb = (float*)(ws + WS_MB);
          att::Seam S; const int tida = TID;
          for (int c = BIDX; c < 256; c += G) {
              const int h = c & 7, x = c >> 3, half = x >> 4;
#define ATT_REF(qb_) att::BlockRef{Q8b + h * 128 + (size_t)(qb_) * 256 * 1024, K8b + h * 128 + (size_t)(half * 2 * ((qb_) + 1)) * 64 * 1024, V8b + (size_t)h * 128 * SEQ + (size_t)(half * 2 * ((qb_) + 1)) * 64, \
                  OPb + (size_t)((h * 32 + (qb_)) * 2 + half) * 256 * 128, MLb + (size_t)((h * 32 + (qb_)) * 2 + half) * 256 * 2, Mb + (size_t)(qb_) * 256 * att::PM + half * 2 * ((qb_) + 1), 2 * ((qb_) + 1)}
              const att::BlockRef u0 = ATT_REF(31 - x), u1 = ATT_REF(x);
              att::prime(u0, (att::lptr)lds, S, tida);
              att::block(u0, u1, (att::lptr)lds, S, tida);
              att::block(u1, u1, (att::lptr)lds, S, tida);
#undef ATT_REF
          } }
        xcd_barrier(bar); }
        { KArgP q = kargs(); unsigned char* ws = asg(q->ws); const bf16* OPb = (const bf16*)(ws + WS_MF); const float* MLb = (const float*)(ws + WS_MB); unsigned char* Ob = ws + WS_ACAT + 2048;
          constexpr float C2 = 1.4426950408889634f * att::SCALE;
          for (size_t idx = GTID; idx < (size_t)SEQ * 8 * 16; idx += NTHR) {
              const int c8 = (int)(idx & 15), h = (int)((idx >> 4) & 7), t = (int)(idx >> 7), qb = t >> 8, r = t & 255;
              const size_t u0 = (size_t)((h * 32 + qb) * 2) * 256 + r, u1 = u0 + 256;
              const att::f32x2v ml0 = *(const att::f32x2v*)(MLb + u0 * 2), ml1 = *(const att::f32x2v*)(MLb + u1 * 2);
              const float m = fmaxf(ml0.x, ml1.x), w0 = __builtin_amdgcn_exp2f((ml0.x - m) * C2), w1 = __builtin_amdgcn_exp2f((ml1.x - m) * C2);
              const float inv = 1.0f / (ml0.y * w0 + ml1.y * w1), a0 = w0 * inv, a1 = w1 * inv;
              float p[8], q8[8], v[8]; ld8(OPb + u0 * 128 + c8 * 8, p); ld8(OPb + u1 * 128 + c8 * 8, q8);
#pragma unroll
              for (int e = 0; e < 8; ++e) v[e] = p[e] * a0 + q8[e] * a1;
              v2u w8; w8.x = f8x4(v[0] * 16.f, v[1] * 16.f, v[2] * 16.f, v[3] * 16.f); w8.y = f8x4(v[4] * 16.f, v[5] * 16.f, v[6] * 16.f, v[7] * 16.f);
              *(v2u*)(Ob + (size_t)t * (MROW * 2) + h * 128 + c8 * 8) = w8; } }
        xcd_barrier(bar);
        for (int rp = 0; rp < RP_MRG; ++rp) {
        { KArgP q = kargs(); unsigned char* ws = asg(q->ws); unsigned char* wl = ws + WS_W + (size_t)l * WL_STRIDE;
          pg8::Gemm g{(const bf16*)(ws + WS_ACAT), (const bf16*)(wl + WL_WCAT), SEQ, DM, MROW, MROW, MROW, 0}; pg8::StaticOrder S; S.init(SEQ, DM, G, BIDX);
          EpiMerge E{(const bf16*)(ws + WS_G), (bf16*)(ws + WS_MB)};
          pg8::gemm_phase<EpiMerge, pg8::StaticOrder, false, true, 2>(lds, g, S, E, TID); }
        xcd_barrier(bar); }
        { KArgP q = kargs(); unsigned char* ws = asg(q->ws); unsigned char* wl = ws + WS_W + (size_t)l * WL_STRIDE;
          pg8::Gemm g{(const bf16*)(ws + WS_MB), (const bf16*)(wl + WL_WO), SEQ, DM, DM, DM, DM, 0}; pg8::StaticOrder S; S.init(SEQ, DM, G, BIDX);
          EpiResid E{(l == 0) ? asg(q->in[0]) : (const float*)nullptr, (const bf16*)(ws + WS_HB), (float*)nullptr, (bf16*)(ws + WS_HB), (unsigned char*)nullptr, (float*)(ws + WS_RSS), (LAS float*)(lds + RING_BYTES + 256)};
          pg8::gemm_phase<EpiResid, pg8::StaticOrder, false, true>(lds, g, S, E, TID); }
        xcd_barrier(bar);
        for (int rp = 0; rp < RP_FF1; ++rp) {
        { KArgP q = kargs(); unsigned char* ws = asg(q->ws); unsigned char* wl = ws + WS_W + (size_t)l * WL_STRIDE;
          pg8::Gemm g{(const bf16*)(ws + WS_HB), (const bf16*)(wl + WL_W1), SEQ, DFF, DM, DM, DM, 0}; pg8::StaticOrder S; S.init(SEQ, DFF, G, BIDX);
          EpiRelu2 E{(bf16*)(ws + WS_F), (const float*)(ws + WS_RSS), (LAS float*)(lds + RING_BYTES + 8192), FROW, 0};
          pg8::gemm_phase<EpiRelu2, pg8::StaticOrder, true, true>(lds, g, S, E, TID); }
        xcd_barrier(bar); }
        { KArgP q = kargs(); unsigned char* ws = asg(q->ws); unsigned char* wl = ws + WS_W + (size_t)l * WL_STRIDE;
          pg8::Gemm g{(const bf16*)(ws + WS_F), (const bf16*)(wl + WL_W2), SEQ, DM, FROW, FROW, FROW, 0}; pg8::StaticOrder S; S.init(SEQ, DM, G, BIDX);
          EpiResid E{(const float*)nullptr, (const bf16*)(ws + WS_HB), (l == DEPTH - 1) ? asg(q->out) : (float*)nullptr, (l == DEPTH - 1) ? (bf16*)nullptr : (bf16*)(ws + WS_HB), (l == DEPTH - 1) ? (unsigned char*)nullptr : ws + WS_X8, (float*)(ws + WS_RSS), (LAS float*)(lds + RING_BYTES + 256)};
          pg8::gemm_phase<EpiResid, pg8::StaticOrder, false, true, 2, FF_B16 / 64, 0x7b7b7b7b>(lds, g, S, E, TID);     }
        if (l + 1 < DEPTH) xcd_barrier(bar);
    }
#undef GTID
#undef TID
#undef LANE
#undef GW
#undef BIDX
#undef NTHR
}

extern "C" void kernel_launch(void* const* d_in, const int* in_sizes, int n_in, void* d_out, int out_size, void* d_ws, size_t ws_size, hipStream_t stream) {
    static int grid = 0;
    if (grid == 0) {
        if (n_in != 15 || in_sizes[0] != SEQ * DM || out_size != SEQ * DM || ws_size < WS_END) { fprintf(stderr, "kernel_launch: unexpected shapes / workspace (n_in %d, ws %zu, need %zu)\n", n_in, ws_size, (size_t)WS_END); grid = -1; return; }
        int dev = 0, cus = 0, per_cu = 0;
        if (hipGetDevice(&dev) != hipSuccess || hipDeviceGetAttribute(&cus, hipDeviceAttributeMultiprocessorCount, dev) != hipSuccess) { grid = -1; return; }
        if (hipFuncSetAttribute((const void*)mega_fwd, hipFuncAttributeMaxDynamicSharedMemorySize, LDS_BYTES) != hipSuccess) { fprintf(stderr, "kernel_launch: hipFuncSetAttribute failed\n"); grid = -1; return; }
        if (hipOccupancyMaxActiveBlocksPerMultiprocessor(&per_cu, (const void*)mega_fwd, NWAVES * 64, LDS_BYTES) != hipSuccess || per_cu < 1) { fprintf(stderr, "kernel_launch: occupancy query says %d blocks per CU\n", per_cu); }
        (void)hipGetLastError();
        grid = cus;
    }
    if (grid < 0) return;
    if (hipMemsetAsync((char*)d_ws + WS_CTL, 0, 1 * MiB, stream) != hipSuccess) { fprintf(stderr, "kernel_launch: memset failed\n"); return; }
    MegaArgs a{};
    for (int i = 0; i < 15; ++i) a.in[i] = (const float*)d_in[i];
    a.out = (float*)d_out; a.ws = (unsigned char*)d_ws;
    hipLaunchKernelGGL(mega_fwd, dim3(grid), dim3(NWAVES * 64), LDS_BYTES, stream, a);
}
```

```cpp
#include <hip/hip_runtime.h>
#include <cstdio>
#include <cstdint>

namespace pg8 {
#define PG8_LAS __attribute__((address_space(3)))
typedef unsigned short bf16_t;
typedef short bf16x8 __attribute__((ext_vector_type(8)));
typedef float f32x4 __attribute__((ext_vector_type(4)));
typedef unsigned u32x4 __attribute__((ext_vector_type(4)));
constexpr int BM = 256, BK = 64, HALF = 128, HTB = HALF * BK * 2, STAGE_BYTES = 8 * HTB, NXCD = 8, WGM = 8;

__host__ __device__ __forceinline__ int lds_byte(int r, int c) { const int st = (r >> 4) * 2 + (c >> 5), rr = r & 15, cc = c & 31, ob = rr * 64 + cc * 2; return st * 1024 + (ob ^ (((ob >> 9) & 1) << 5)); }
__host__ __device__ __forceinline__ void stage_rc(int b, int& R, int& C) { const int st = b / 1024, sb = b % 1024, swz = sb ^ (((sb >> 9) & 1) << 5); R = (st >> 1) * 16 + swz / 64; C = (st & 1) * 32 + (swz % 64) / 2; }
__host__ __device__ __forceinline__ int perm32(int rho) { const int n = rho >> 4, i = rho & 15; return 8 * (i >> 2) + 4 * n + (i & 3); }

struct Unit { int pm, pn; };
struct Gemm { const bf16_t* A; const bf16_t* Bt; int M, N, K, lda, ldb, pad; };

struct StaticOrder {
    int nM, nN, nwg, G, c;
    __host__ __device__ void init(int M, int N, int G_, int c_) { nM = M / BM; nN = N / BM; nwg = nM * nN; G = G_; c = c_; }
    __host__ __device__ bool next(int i, Unit& u) const {
        const long L = (long)i * G + c; if (L >= nwg) return false;
        int wgid = (int)L; { const int q = nwg / NXCD, r = nwg % NXCD, xcd = wgid % NXCD, off = wgid / NXCD; wgid = (xcd < r ? xcd * (q + 1) : r * (q + 1) + (xcd - r) * q) + off; }
        const int nig = WGM * nN, gid = wgid / nig, fm = gid * WGM, gsz = (nM - fm) < WGM ? (nM - fm) : WGM;
        u.pm = fm + ((wgid % nig) % gsz); u.pn = (wgid % nig) / gsz; return true;
    }
    __device__ __forceinline__ void a_ready(const Unit&) const {}
    __device__ __forceinline__ void done(const Unit&) const {}
};

__device__ __forceinline__ int opq_v(int x) { asm volatile("" : "+v"(x)); return x; }
typedef int v4i_t __attribute__((ext_vector_type(4))); typedef int v8i_t __attribute__((ext_vector_type(8)));
__device__ __forceinline__ v8i_t cat8(bf16x8 a, bf16x8 b) { return __builtin_shufflevector(__builtin_bit_cast(v4i_t, a), __builtin_bit_cast(v4i_t, b), 0, 1, 2, 3, 4, 5, 6, 7); }
__device__ __forceinline__ int opq_s(int x) { asm volatile("" : "+s"(x)); return x; }
__device__ __forceinline__ int lane_now() { unsigned m = ~0u; asm volatile("" : "+s"(m)); return (int)__builtin_amdgcn_mbcnt_hi(m, __builtin_amdgcn_mbcnt_lo(m, 0u)); }
__device__ __forceinline__ unsigned cvt_pk_bf16(float lo, float hi) { unsigned r; asm volatile("v_cvt_pk_bf16_f32 %0, %1, %2" : "=v"(r) : "v"(lo), "v"(hi)); return r; }

template <class Epi, class Sched, bool ALIGN_EPI = false, bool SP2 = false, int MODE = 0, int SPLIT = 16, int F8SC = 0x7f7f7f7f>
__device__ __forceinline__ void gemm_phase(PG8_LAS unsigned char* lds, const Gemm g, const Sched& S, const Epi& E, const int tid) {
    const int wid = __builtin_amdgcn_readfirstlane(tid >> 6), lane = tid & 63, wr = wid >> 2, wc = wid & 3, fr = lane & 15, fq = lane >> 4;
    const int K = g.K, nt = K / BK;
    unsigned voffA[2], voffB[2];
#pragma unroll
    for (int i = 0; i < 2; ++i) { int R, C; stage_rc(tid * 16 + i * 8192, R, C); const int Rb = Epi::PERM ? ((R & ~31) + perm32(R & 31)) : R;
        voffA[i] = (unsigned)(R * g.lda + C) * 2u; voffB[i] = (unsigned)(Rb * g.ldb + C) * 2u; }
    const size_t kstep = (size_t)(BK * 2);
    const size_t hstepA = (size_t)HALF * g.lda * 2, hstepB = (size_t)HALF * g.ldb * 2;
    const size_t tstepA = 2 * hstepA, tstepB = 2 * hstepB;
    const unsigned ldsw = (unsigned)wid * 1024u;
    const int aoff = lds_byte(wr * 64 + fr, fq * 8), boff = lds_byte(wc * 32 + fr, fq * 8);
#define PG8_SA(b, h) (((b) * 2 + (h)) * HTB)
#define PG8_SB(b, h) ((4 + (b) * 2 + (h)) * HTB)
#define PG8_STAGE(bufoff, gbase, voff) do { _Pragma("unroll") for (int _i = 0; _i < 2; ++_i) \
        __builtin_amdgcn_global_load_lds((const unsigned*)((const char*)(gbase) + (voff)[_i]), (PG8_LAS unsigned*)(lds + (bufoff) + ldsw + _i * 8192), 16, 0, 0); } while (0)
#define PG8_LD8(p) cat8(*(const PG8_LAS bf16x8*)(p), *(const PG8_LAS bf16x8*)((p) + 1024))
#define PG8_LDA(F8L, dst, b, h) do { _Pragma("unroll") for (int m = 0; m < 4; ++m) { if constexpr (F8L) dst##8[m] = PG8_LD8(lds + PG8_SA(b, h) + aoff + m * 2048); else { _Pragma("unroll") for (int k = 0; k < 2; ++k) dst[m][k] = *(const PG8_LAS bf16x8*)(lds + PG8_SA(b, h) + aoff + m * 2048 + k * 1024); } } } while (0)
#define PG8_LDB(F8L, dst, b, h) do { _Pragma("unroll") for (int n = 0; n < 2; ++n) { if constexpr (F8L) dst##8[n] = PG8_LD8(lds + PG8_SB(b, h) + boff + n * 2048); else { _Pragma("unroll") for (int k = 0; k < 2; ++k) dst[n][k] = *(const PG8_LAS bf16x8*)(lds + PG8_SB(b, h) + boff + n * 2048 + k * 1024); } } } while (0)
#define PG8_MMA(F8L, ai, bj, At, Bt) do { __builtin_amdgcn_s_setprio(1); _Pragma("unroll") for (int m = 0; m < 4; ++m) _Pragma("unroll") for (int n = 0; n < 2; ++n) { \
        if constexpr (F8L) asm volatile("v_mfma_scale_f32_16x16x128_f8f6f4 %0, %1, %2, %0, %3, %3 op_sel_hi:[0,0,0]" : "+v"(acc[ai][bj][m][n]) : "v"(Bt##8[n]), "v"(At##8[m]), "v"(f8scale));   \
        else { _Pragma("unroll") for (int k = 0; k < 2; ++k) acc[ai][bj][m][n] = __builtin_amdgcn_mfma_f32_16x16x32_bf16(Bt[n][k], At[m][k], acc[ai][bj][m][n], 0, 0, 0); } } __builtin_amdgcn_s_setprio(0); } while (0)
#define PG8_WAIT_V(n) asm volatile("s_waitcnt vmcnt(" #n ")" ::: "memory")
#define PG8_WAIT_L(n) asm volatile("s_waitcnt lgkmcnt(" #n ")" ::: "memory")
#define PG8_BAR __builtin_amdgcn_s_barrier()
#define PG8_SCHED __builtin_amdgcn_sched_barrier(0)
    Unit cur, nxt; int ui = 0;
    if (!S.next(0, cur)) return;
    f32x4 acc[2][2][4][2];
#pragma unroll
    for (int a = 0; a < 2; ++a)
#pragma unroll
        for (int b = 0; b < 2; ++b)
#pragma unroll
            for (int m = 0; m < 4; ++m)
#pragma unroll
                for (int n = 0; n < 2; ++n) acc[a][b][m][n] = (f32x4){0.f, 0.f, 0.f, 0.f};
    const int f8scale = opq_v(F8SC);
    bf16x8 At[4][2], B0[2][2], B1[2][2]; v8i_t At8[4], B08[2], B18[2];
    const char* cA = (const char*)g.A + (size_t)cur.pm * tstepA; const char* cB = (const char*)g.Bt + (size_t)cur.pn * tstepB;
    S.a_ready(cur);
    if constexpr (SP2) {
        PG8_STAGE(PG8_SB(0, 0), cB, voffB); PG8_STAGE(PG8_SB(0, 1), cB + hstepB, voffB); PG8_STAGE(PG8_SA(0, 0), cA, voffA); PG8_STAGE(PG8_SA(0, 1), cA + hstepA, voffA);
        if (wr == 1) PG8_BAR;
        PG8_WAIT_V(2); PG8_BAR;
        PG8_STAGE(PG8_SB(1, 0), cB + kstep, voffB); PG8_STAGE(PG8_SA(1, 0), cA + kstep, voffA); PG8_STAGE(PG8_SB(1, 1), cB + hstepB + kstep, voffB);
        PG8_WAIT_V(6); PG8_BAR;
    } else {
        PG8_STAGE(PG8_SB(0, 0), cB, voffB); PG8_STAGE(PG8_SA(0, 0), cA, voffA); PG8_STAGE(PG8_SB(0, 1), cB + hstepB, voffB); PG8_STAGE(PG8_SA(0, 1), cA + hstepA, voffA);
        if (wr == 1) PG8_BAR;
        PG8_WAIT_V(4); PG8_BAR;
        PG8_STAGE(PG8_SB(1, 0), cB + kstep, voffB); PG8_STAGE(PG8_SA(1, 0), cA + kstep, voffA); PG8_STAGE(PG8_SB(1, 1), cB + hstepB + kstep, voffB);
        PG8_WAIT_V(6); PG8_BAR;
    }
    for (;;) {
        const bool has_next = S.next(ui + 1, nxt);
        const char* nA = has_next ? (const char*)g.A + (size_t)nxt.pm * tstepA : cA; const char* nB = has_next ? (const char*)g.Bt + (size_t)nxt.pn * tstepB : cB;
#define PG8_KHEAD() \
            const bool last = (t == nt - 2); \
            const char* a1 = cA + (size_t)(t + 1) * kstep; \
            const char* a2 = last ? nA : cA + (size_t)(t + 2) * kstep; const char* b2 = last ? nB : cB + (size_t)(t + 2) * kstep; \
            const char* a3 = a2 + kstep; const char* b3 = b2 + kstep; \
            if (last && has_next) S.a_ready(nxt); \
            if constexpr (Epi::SEGMENTS) { if (Epi::hook(t)) E.mid(acc, cur, t, wr, wc, fr, fq); }
#define PG8_ITER_SP2(F8L) do { bf16x8 At[4][2], B0[2][2], B1[2][2]; v8i_t At8[4], B08[2], B18[2];     \
            PG8_LDB(F8L, B0, 0, 0); PG8_LDB(F8L, B1, 0, 1); PG8_SCHED; PG8_LDA(F8L, At, 0, 0); PG8_STAGE(PG8_SA(1, 1), a1 + hstepA, voffA); \
            PG8_WAIT_V(8); PG8_WAIT_L(0); PG8_BAR; PG8_MMA(F8L, 0, 0, At, B0); PG8_MMA(F8L, 0, 1, At, B1); PG8_BAR; PG8_SCHED; \
            PG8_LDA(F8L, At, 0, 1); PG8_STAGE(PG8_SB(0, 0), b2, voffB); PG8_STAGE(PG8_SB(0, 1), b2 + hstepB, voffB); PG8_STAGE(PG8_SA(0, 0), a2, voffA); \
            PG8_WAIT_V(8); PG8_WAIT_L(0); PG8_BAR; PG8_MMA(F8L, 1, 0, At, B0); PG8_MMA(F8L, 1, 1, At, B1); PG8_BAR; PG8_SCHED; \
            PG8_LDB(F8L, B0, 1, 0); PG8_LDB(F8L, B1, 1, 1); PG8_SCHED; PG8_LDA(F8L, At, 1, 0); PG8_STAGE(PG8_SA(0, 1), a2 + hstepA, voffA); \
            PG8_WAIT_V(8); PG8_WAIT_L(0); PG8_BAR; PG8_MMA(F8L, 0, 0, At, B0); PG8_MMA(F8L, 0, 1, At, B1); PG8_BAR; PG8_SCHED; \
            PG8_LDA(F8L, At, 1, 1); PG8_STAGE(PG8_SB(1, 0), b3, voffB); PG8_STAGE(PG8_SB(1, 1), b3 + hstepB, voffB); PG8_STAGE(PG8_SA(1, 0), a3, voffA); \
            PG8_WAIT_V(8); PG8_WAIT_L(0); PG8_BAR; PG8_MMA(F8L, 1, 0, At, B0); PG8_MMA(F8L, 1, 1, At, B1); PG8_BAR; PG8_SCHED; } while (0)
        if constexpr (SP2 && MODE == 2) {
            int t = 0;
            for (; t < SPLIT; t += 2) { PG8_KHEAD() PG8_ITER_SP2(false); }
            for (; t < nt; t += 2) { PG8_KHEAD() PG8_ITER_SP2(true); }
        } else if constexpr (SP2) {
            for (int t = 0; t < nt; t += 2) { PG8_KHEAD() if constexpr (MODE == 1) PG8_ITER_SP2(true); else PG8_ITER_SP2(false); }
        } else {
        for (int t = 0; t < nt; t += 2) {
            PG8_KHEAD()
            {
            static_assert(SP2 || MODE == 0, "fp8 K-tiles need the SP2 loop");
            PG8_LDB(false, B0, 0, 0); PG8_SCHED; PG8_LDA(false, At, 0, 0); PG8_STAGE(PG8_SA(1, 1), a1 + hstepA, voffA);
            PG8_WAIT_L(8); PG8_BAR; PG8_WAIT_L(0); PG8_MMA(false, 0, 0, At, B0); PG8_BAR; PG8_SCHED;
            PG8_LDB(false, B1, 0, 1); PG8_STAGE(PG8_SB(0, 0), b2, voffB);
            PG8_BAR; PG8_WAIT_L(0); PG8_MMA(false, 0, 1, At, B1); PG8_BAR;
            PG8_LDA(false, At, 0, 1); PG8_STAGE(PG8_SA(0, 0), a2, voffA);
            PG8_BAR; PG8_WAIT_L(0); PG8_MMA(false, 1, 0, At, B0); PG8_BAR; PG8_SCHED;
            PG8_STAGE(PG8_SB(0, 1), b2 + hstepB, voffB);
            PG8_WAIT_V(6); PG8_BAR; PG8_MMA(false, 1, 1, At, B1); PG8_BAR;
            PG8_LDB(false, B0, 1, 0); PG8_SCHED; PG8_LDA(false, At, 1, 0); PG8_STAGE(PG8_SA(0, 1), a2 + hstepA, voffA);
            PG8_WAIT_L(8); PG8_BAR; PG8_WAIT_L(0); PG8_MMA(false, 0, 0, At, B0); PG8_BAR; PG8_SCHED;
            PG8_LDB(false, B1, 1, 1); PG8_STAGE(PG8_SB(1, 0), b3, voffB);
            PG8_BAR; PG8_WAIT_L(0); PG8_MMA(false, 0, 1, At, B1); PG8_BAR;
            PG8_LDA(false, At, 1, 1); PG8_STAGE(PG8_SA(1, 0), a3, voffA);
            PG8_BAR; PG8_WAIT_L(0); PG8_MMA(false, 1, 0, At, B0); PG8_BAR; PG8_SCHED;
            PG8_STAGE(PG8_SB(1, 1), b3 + hstepB, voffB);
            PG8_WAIT_V(6); PG8_BAR; PG8_MMA(false, 1, 1, At, B1); PG8_BAR;
            }
        }
        }
#undef PG8_ITER_SP2
#undef PG8_KHEAD
        if constexpr (ALIGN_EPI) { if (wr == 0) PG8_BAR; }
        if constexpr (MODE != 0) asm volatile("s_nop 15\n\ts_nop 15" ::: "memory");
        E(acc, cur, wr, wc, fr, fq); S.done(cur);
        if (!has_next) break;
#pragma unroll
        for (int a = 0; a < 2; ++a)
#pragma unroll
            for (int b = 0; b < 2; ++b)
#pragma unroll
                for (int m = 0; m < 4; ++m)
#pragma unroll
                    for (int n = 0; n < 2; ++n) acc[a][b][m][n] = (f32x4){0.f, 0.f, 0.f, 0.f};
        cur = nxt; cA = nA; cB = nB; ++ui;
        if constexpr (ALIGN_EPI) { if (wr == 1) PG8_BAR; }
    }
    PG8_WAIT_V(0);
    if constexpr (!ALIGN_EPI) { if (wr == 0) PG8_BAR; }
    PG8_BAR;
#undef PG8_SA
#undef PG8_SB
#undef PG8_STAGE
#undef PG8_LDA
#undef PG8_LDB
#undef PG8_MMA
#undef PG8_WAIT_V
#undef PG8_WAIT_L
#undef PG8_BAR
#undef PG8_SCHED
}
}

constexpr int SEQ = 8192, DM = 2048, DEPTH = 4, DFF = 8192;
constexpr int FF_B16 = 6144, FF_F8 = DFF - FF_B16, FROW = FF_B16 + FF_F8 / 2;
constexpr int INW = 11848;
constexpr int INW_PAD = 12032;
constexpr int GATE_REF0 = 5704, GATE_PAD0 = 5888;
constexpr float EPS = 1e-6f;

typedef unsigned short bf16;
typedef unsigned v4u __attribute__((ext_vector_type(4)));
typedef unsigned v2u __attribute__((ext_vector_type(2)));
typedef float f32x4 __attribute__((ext_vector_type(4)));
typedef float f32x16 __attribute__((ext_vector_type(16)));
typedef short bf16x8 __attribute__((ext_vector_type(8)));
#define LAS __attribute__((address_space(3)))

constexpr size_t MiB = 1u << 20;
constexpr size_t WS_CTL = 0;
constexpr size_t WS_W = 2 * MiB;
constexpr size_t WL_WIN = 0, WL_WCAT = 47 * MiB, WL_WO = 55 * MiB, WL_W1 = 63 * MiB, WL_W2 = 95 * MiB, WL_STRIDE = 127 * MiB;
constexpr size_t WS_X = 512 * MiB;
constexpr size_t WS_HB = 576 * MiB;
constexpr size_t WS_PC = 608 * MiB;
constexpr size_t WS_Q = 640 * MiB, WS_K = 656 * MiB, WS_V = 672 * MiB;
constexpr size_t WS_QI = 688 * MiB;
constexpr size_t WS_KI = 696 * MiB;
constexpr size_t WS_WI = 697 * MiB;
constexpr size_t WS_ACAT = 704 * MiB;
constexpr size_t WS_G = 736 * MiB;
constexpr size_t WS_MASK = 832 * MiB;
constexpr size_t WS_MF = 840 * MiB;
constexpr size_t WS_MB = 904 * MiB;
constexpr size_t WS_S = 936 * MiB;
constexpr size_t WS_F = 936 * MiB;
constexpr size_t WS_X8 = 1192 * MiB;
constexpr size_t WS_WG8 = 1208 * MiB;
constexpr size_t WS_END = 1280 * MiB;
constexpr int NB16 = 2816;
constexpr int MROW = 1536;
constexpr int NF8 = 9216;

__device__ __forceinline__ unsigned f2bf(float f) { unsigned u = __builtin_bit_cast(unsigned, f); return (u + 0x7fffu + ((u >> 16) & 1u)) >> 16; }
__device__ __forceinline__ unsigned pk2(float lo, float hi) { return f2bf(lo) | (f2bf(hi) << 16); }
__device__ __forceinline__ float bflo(unsigned w) { return __builtin_bit_cast(float, w << 16); }
__device__ __forceinline__ float bfhi(unsigned w) { return __builtin_bit_cast(float, w & 0xffff0000u); }
__device__ __forceinline__ float shx(float v, int lane, int o) { return __builtin_bit_cast(float, __builtin_amdgcn_ds_bpermute((lane ^ o) << 2, __builtin_bit_cast(int, v))); }
__device__ __forceinline__ int shi(int v, int src) { return __builtin_amdgcn_ds_bpermute(src << 2, v); }
__device__ __forceinline__ float wave_sum(float v, int lane) {
#pragma unroll
    for (int o = 1; o < 64; o <<= 1) v += shx(v, lane, o);
    return v;
}

__device__ __forceinline__ float f8clamp(float v) { return __builtin_amdgcn_fmed3f(v, -448.f, 448.f); }
__device__ __forceinline__ unsigned u8x4(float a, float b, float c, float d) {
    unsigned w = 0; w = __builtin_amdgcn_cvt_pk_u8_f32(fmaxf(__builtin_rintf(a * 255.f), 1.f), 0, w); w = __builtin_amdgcn_cvt_pk_u8_f32(fmaxf(__builtin_rintf(b * 255.f), 1.f), 1, w);
    w = __builtin_amdgcn_cvt_pk_u8_f32(fmaxf(__builtin_rintf(c * 255.f), 1.f), 2, w); w = __builtin_amdgcn_cvt_pk_u8_f32(fmaxf(__builtin_rintf(d * 255.f), 1.f), 3, w); return w; }
__device__ __forceinline__ float ub0(unsigned w) { return (float)(w & 255u); }
__device__ __forceinline__ float ub1(unsigned w) { return (float)((w >> 8) & 255u); }
__device__ __forceinline__ float ub2(unsigned w) { return (float)((w >> 16) & 255u); }
__device__ __forceinline__ float ub3(unsigned w) { return (float)(w >> 24); }
__device__ __forceinline__ unsigned f8x4(float a, float b, float c, float d) { int w = 0; w = __builtin_amdgcn_cvt_pk_fp8_f32(f8clamp(a), f8clamp(b), w, false); w = __builtin_amdgcn_cvt_pk_fp8_f32(f8clamp(c), f8clamp(d), w, true); return (unsigned)w; }
__device__ __forceinline__ float row_rinv(const float* rss) {
    const f32x4 a = *(const f32x4*)rss, b = *(const f32x4*)(rss + 4);
    return 1.0f / sqrtf((((a.x + a.y) + (a.z + a.w)) + ((b.x + b.y) + (b.z + b.w))) * (1.f / DM) + EPS);
}

struct EpiInProj {
    static constexpr bool PERM = true, SEGMENTS = false;
    bf16 *PC, *Q, *K, *V, *QI, *KI, *G; float* WI; const float* RSS; LAS float* rl;
    __device__ __forceinline__ void operator()(const pg8::f32x4 (&acc_in)[2][2][4][2], const pg8::Unit& u, int wr, int wc, int fr, int fq) const {
        const int row0 = u.pm * 256 + wr * 64 + fr, cl = wc * 32 + 8 * fq, pn = u.pn;
        pg8::f32x4 acc[2][2][4][2];
        if (wr == 0) rl[wc * 64 + fr + 16 * fq] = row_rinv(RSS + (size_t)(u.pm * 256 + wc * 64 + fr + 16 * fq) * 8);
        asm volatile("s_waitcnt lgkmcnt(0)" ::: "memory"); __builtin_amdgcn_s_barrier(); asm volatile("" ::: "memory");
#pragma unroll
        for (int ai = 0; ai < 2; ++ai)
#pragma unroll
            for (int m = 0; m < 4; ++m) { const float ri = rl[wr * 64 + ai * 128 + m * 16 + fr];
#pragma unroll
                for (int bj = 0; bj < 2; ++bj)
#pragma unroll
                    for (int n = 0; n < 2; ++n) acc[ai][bj][m][n] = acc_in[ai][bj][m][n] * ri; }
        if (pn == 10) {
#pragma unroll
            for (int ai = 0; ai < 2; ++ai)
#pragma unroll
                for (int m = 0; m < 4; ++m) { const int row = row0 + ai * 128 + m * 16; const pg8::f32x4 v0 = acc[ai][0][m][0], v1 = acc[ai][0][m][1];
                    if (cl < 64) { v4u w; w.x = pg8::cvt_pk_bf16(v0[0], v0[1]); w.y = pg8::cvt_pk_bf16(v0[2], v0[3]); w.z = pg8::cvt_pk_bf16(v1[0], v1[1]); w.w = pg8::cvt_pk_bf16(v1[2], v1[3]);
                        *(v4u*)(KI + (size_t)row * 64 + cl) = w; }
                    else if (cl == 64) { *(f32x4*)(WI + (size_t)row * 8) = v0; *(f32x4*)(WI + (size_t)row * 8 + 4) = v1; } }
            return;
        }
        bf16* base; int ldc, colt; const bool sig = false;
        if (pn < 8) { base = PC; ldc = 2048; colt = pn * 256; }
        else { base = QI; ldc = 512; colt = (pn - 8) * 256; }
#pragma unroll
        for (int ai = 0; ai < 2; ++ai)
#pragma unroll
            for (int m = 0; m < 4; ++m) { bf16* rowp = base + (size_t)(row0 + ai * 128 + m * 16) * ldc + colt + cl;
#pragma unroll
                for (int bj = 0; bj < 2; ++bj) { pg8::f32x4 v0 = acc[ai][bj][m][0], v1 = acc[ai][bj][m][1];
                    if (sig) {
#pragma unroll
                        for (int j = 0; j < 4; ++j) { v0[j] = __builtin_amdgcn_rcpf(1.f + __builtin_amdgcn_exp2f(-1.44269504f * v0[j])); v1[j] = __builtin_amdgcn_rcpf(1.f + __builtin_amdgcn_exp2f(-1.44269504f * v1[j])); } }
                    v4u w; w.x = pg8::cvt_pk_bf16(v0[0], v0[1]); w.y = pg8::cvt_pk_bf16(v0[2], v0[3]); w.z = pg8::cvt_pk_bf16(v1[0], v1[1]); w.w = pg8::cvt_pk_bf16(v1[2], v1[3]);
                    *(v4u*)(rowp + bj * 128) = w; } }
    }
};
struct EpiGate {
    static constexpr bool PERM = true, SEGMENTS = false;
    bf16 *Q, *K, *V, *G; const float* RSS; LAS float* rl; unsigned char* Q8; const float* qg; const float* kg; LAS float* xq;
    __device__ __forceinline__ void qk_tile(const pg8::f32x4 (&acc_in)[2][2][4][2], const pg8::Unit& u, int wr, int wc, int fr, int fq) const {
        const int pn = u.pn, lane = fr + 16 * fq, cl = wc * 32 + 8 * fq;
        pg8::f32x4 a[2][2][4][2]; float ss[2][4][2];
#pragma unroll
        for (int ai = 0; ai < 2; ++ai)
#pragma unroll
            for (int m = 0; m < 4; ++m) { const float rs = rl[wr * 64 + ai * 128 + m * 16 + fr] * (-1.0f / 1.44269504f);
#pragma unroll
                for (int bj = 0; bj < 2; ++bj) { const pg8::f32x4 v0 = acc_in[ai][bj][m][0] * rs, v1 = acc_in[ai][bj][m][1] * rs; a[ai][bj][m][0] = v0; a[ai][bj][m][1] = v1;
                    float s = (v0[0] * v0[0] + v0[1] * v0[1]) + (v0[2] * v0[2] + v0[3] * v0[3]) + (v1[0] * v1[0] + v1[1] * v1[1]) + (v1[2] * v1[2] + v1[3] * v1[3]);
                    s += shx(s, lane, 16); s += shx(s, lane, 32); ss[ai][m][bj] = s; } }
        if (fq == 0) {
#pragma unroll
            for (int ai = 0; ai < 2; ++ai)
#pragma unroll
                for (int m = 0; m < 4; ++m)
#pragma unroll
                    for (int bj = 0; bj < 2; ++bj) xq[((wr * 64 + ai * 128 + m * 16 + fr) * 2 + bj) * 4 + wc] = ss[ai][m][bj]; }
        asm volatile("s_waitcnt lgkmcnt(0)" ::: "memory"); __builtin_amdgcn_s_barrier(); asm volatile("" ::: "memory");
        const float* gn = (pn < 4 ? qg : kg) + cl; const f32x4 g0 = *(const f32x4*)gn, g1 = *(const f32x4*)(gn + 4);
        unsigned char* dst = Q8 + (size_t)(pn >> 2) * (8 * MiB) + (size_t)(u.pm * 256 + wr * 64 + fr) * 1024 + (pn & 3) * 256 + cl;
#pragma unroll
        for (int ai = 0; ai < 2; ++ai)
#pragma unroll
            for (int m = 0; m < 4; ++m)
#pragma unroll
                for (int bj = 0; bj < 2; ++bj) { const pg8::f32x4 p = *(const LAS pg8::f32x4*)(xq + ((wr * 64 + ai * 128 + m * 16 + fr) * 2 + bj) * 4);
                    const float rinv = 1.0f / sqrtf(((p[0] + p[1]) + (p[2] + p[3])) * (1.f / 128.f) + EPS);
                    const pg8::f32x4 v0 = a[ai][bj][m][0] * rinv, v1 = a[ai][bj][m][1] * rinv;
                    v2u w; w.x = f8x4(v0[0] * g0[0], v0[1] * g0[1], v0[2] * g0[2], v0[3] * g0[3]); w.y = f8x4(v1[0] * g1[0], v1[1] * g1[1], v1[2] * g1[2], v1[3] * g1[3]);
                    *(v2u*)(dst + (size_t)(ai * 128 + m * 16) * 1024 + bj * 128) = w; }
    }
    __device__ __forceinline__ void operator()(const pg8::f32x4 (&acc)[2][2][4][2], const pg8::Unit& u, int wr, int wc, int fr, int fq) const {
        const int row0 = u.pm * 256 + wr * 64 + fr, pn = u.pn; const bool gate = pn >= 12;
        static_assert(WS_K - WS_Q == WS_V - WS_K, "q|k|v buffers equally spaced");
        bf16* base = gate ? G + (pn - 12) * 256 : Q + (size_t)(pn >> 2) * ((WS_K - WS_Q) / 2) + (pn & 3) * 256; const int ldc = gate ? 6144 : 1024; base += wc * 32 + 8 * fq;
        if (wr == 0) rl[wc * 64 + fr + 16 * fq] = row_rinv(RSS + (size_t)(u.pm * 256 + wc * 64 + fr + 16 * fq) * 8) * (-1.44269504f / 32.f);
        asm volatile("s_waitcnt lgkmcnt(0)" ::: "memory"); __builtin_amdgcn_s_barrier(); asm volatile("" ::: "memory");
        if (pn < 8) { qk_tile(acc, u, wr, wc, fr, fq); return; }
#pragma unroll
        for (int ai = 0; ai < 2; ++ai)
#pragma unroll
            for (int m = 0; m < 4; ++m) { const int row = row0 + ai * 128 + m * 16; const float ri = rl[wr * 64 + ai * 128 + m * 16 + fr];
                bf16* rowp = base + (size_t)row * ldc;
#pragma unroll
                for (int bj = 0; bj < 2; ++bj) { pg8::f32x4 v0 = acc[ai][bj][m][0], v1 = acc[ai][bj][m][1];
                    if (gate) {
#pragma unroll
                        for (int j = 0; j < 4; ++j) { v0[j] = __builtin_amdgcn_rcpf(1.f + __builtin_amdgcn_exp2f(ri * v0[j])); v1[j] = __builtin_amdgcn_rcpf(1.f + __builtin_amdgcn_exp2f(ri * v1[j])); }
                        v2u w8; w8.x = u8x4(v0[0], v0[1], v0[2], v0[3]); w8.y = u8x4(v1[0], v1[1], v1[2], v1[3]);
                        *(v2u*)((unsigned char*)G + (size_t)row * 6144 + (pn - 12) * 256 + wc * 32 + 8 * fq + bj * 128) = w8; continue; }
                    else { const float rs = ri * (-1.0f / 1.44269504f); v0 *= rs; v1 *= rs; }
                    v4u w; w.x = pg8::cvt_pk_bf16(v0[0], v0[1]); w.y = pg8::cvt_pk_bf16(v0[2], v0[3]); w.z = pg8::cvt_pk_bf16(v1[0], v1[1]); w.w = pg8::cvt_pk_bf16(v1[2], v1[3]);
                    *(v4u*)(rowp + bj * 128) = w; } }
    }
};
__device__ __forceinline__ float gclamp(float g) { return fmaxf(g, 1e-20f); }
struct EpiMerge {
    static constexpr bool PERM = true, SEGMENTS = true;
    static __device__ __forceinline__ bool hook(int t) { return t == 8 || t == 16; }
    const bf16* G; bf16* MB;
    __device__ __forceinline__ void mid(pg8::f32x4 (&acc)[2][2][4][2], const pg8::Unit& u, int t, int wr, int wc, int fr, int fq) const {
        const int row0 = pg8::opq_v(u.pm * 256 + wr * 64 + fr), col0 = u.pn * 256 + wc * 32 + 8 * fq, b = (t == 8) ? 0 : 1; const float sc = (t == 8) ? 1.f : 512.f;
        v2u gn[2][2][2], gd[2][2][2];
#define MRG_LD(q_, buf_) do { _Pragma("unroll") for (int mm = 0; mm < 2; ++mm) { const unsigned char* gp = (const unsigned char*)G + (size_t)(row0 + ((q_) >> 1) * 128 + (((q_) & 1) * 2 + mm) * 16) * 6144 + b * 2048 + col0; \
            _Pragma("unroll") for (int bj = 0; bj < 2; ++bj) { gn[buf_][mm][bj] = *(const v2u*)(gp + bj * 128); gd[buf_][mm][bj] = *(const v2u*)(gp + 2048 + bj * 128); } } } while (0)
        MRG_LD(0, 0);
#pragma unroll
        for (int q = 0; q < 4; ++q) { const int ai = q >> 1, mp = q & 1, bf = q & 1;
            if (q + 1 < 4) { if (bf == 0) MRG_LD(q + 1, 1); else MRG_LD(q + 1, 0); }
#pragma unroll
            for (int mm = 0; mm < 2; ++mm)
#pragma unroll
                for (int bj = 0; bj < 2; ++bj) { const v2u n4 = gn[bf][mm][bj], d4 = gd[bf][mm][bj];
                    pg8::f32x4& v0 = acc[ai][bj][mp * 2 + mm][0]; pg8::f32x4& v1 = acc[ai][bj][mp * 2 + mm][1];
                    v0[0] *= sc * ub0(n4.x) * __builtin_amdgcn_rcpf(ub0(d4.x)); v0[1] *= sc * ub1(n4.x) * __builtin_amdgcn_rcpf(ub1(d4.x));
                    v0[2] *= sc * ub2(n4.x) * __builtin_amdgcn_rcpf(ub2(d4.x)); v0[3] *= sc * ub3(n4.x) * __builtin_amdgcn_rcpf(ub3(d4.x));
                    v1[0] *= sc * ub0(n4.y) * __builtin_amdgcn_rcpf(ub0(d4.y)); v1[1] *= sc * ub1(n4.y) * __builtin_amdgcn_rcpf(ub1(d4.y));
                    v1[2] *= sc * ub2(n4.y) * __builtin_amdgcn_rcpf(ub2(d4.y)); v1[3] *= sc * ub3(n4.y) * __builtin_amdgcn_rcpf(ub3(d4.y));
                    asm volatile("" : "+v"(v0), "+v"(v1) :: "memory"); } }
#undef MRG_LD
    }
    __device__ __forceinline__ void operator()(const pg8::f32x4 (&acc)[2][2][4][2], const pg8::Unit& u, int wr, int wc, int fr, int fq) const {
        const int row0 = u.pm * 256 + wr * 64 + fr, col0 = u.pn * 256 + wc * 32 + 8 * fq;
#pragma unroll
        for (int ai = 0; ai < 2; ++ai)
#pragma unroll
            for (int m = 0; m < 4; ++m) { const int row = row0 + ai * 128 + m * 16;
#pragma unroll
                for (int bj = 0; bj < 2; ++bj) { const int c = col0 + bj * 128;
                    const v2u gw = *(const v2u*)((const unsigned char*)G + (size_t)row * 6144 + 2 * 2048 + c);
                    pg8::f32x4 v0 = acc[ai][bj][m][0], v1 = acc[ai][bj][m][1];
                    constexpr float IS = 1.f / (512.f * 255.f);
                    v0[0] *= IS * ub0(gw.x); v0[1] *= IS * ub1(gw.x); v0[2] *= IS * ub2(gw.x); v0[3] *= IS * ub3(gw.x);
                    v1[0] *= IS * ub0(gw.y); v1[1] *= IS * ub1(gw.y); v1[2] *= IS * ub2(gw.y); v1[3] *= IS * ub3(gw.y);
                    v4u w; w.x = pg8::cvt_pk_bf16(v0[0], v0[1]); w.y = pg8::cvt_pk_bf16(v0[2], v0[3]); w.z = pg8::cvt_pk_bf16(v1[0], v1[1]); w.w = pg8::cvt_pk_bf16(v1[2], v1[3]);
                    *(v4u*)(MB + (size_t)row * 2048 + c) = w; } }
    }
};
struct EpiResid {
    static constexpr bool PERM = false, SEGMENTS = false;
    const float* base32; const bf16* base16; float* out32; bf16* XB; unsigned char* X8; float* RSS; LAS float* xl;
    __device__ __forceinline__ void operator()(const pg8::f32x4 (&acc)[2][2][4][2], const pg8::Unit& u, int wr, int wc, int fr, int fq) const {
        const int row0 = u.pm * 256 + wr * 64 + fr, col0 = u.pn * 256 + wc * 32 + 4 * fq, lane = fr + 16 * fq;
#pragma unroll
        for (int ai = 0; ai < 2; ++ai) {
            pg8::f32x4 bb[4][2][2];
            if (base32) {
#pragma unroll
                for (int m = 0; m < 4; ++m)
#pragma unroll
                    for (int bj = 0; bj < 2; ++bj)
#pragma unroll
                        for (int n = 0; n < 2; ++n) bb[m][bj][n] = *(const pg8::f32x4*)(base32 + (size_t)(row0 + ai * 128 + m * 16) * DM + col0 + bj * 128 + n * 16);
            } else {
                v2u rw[4][2][2];
#pragma unroll
                for (int m = 0; m < 4; ++m)
#pragma unroll
                    for (int bj = 0; bj < 2; ++bj)
#pragma unroll
                        for (int n = 0; n < 2; ++n) rw[m][bj][n] = *(const v2u*)(base16 + (size_t)(row0 + ai * 128 + m * 16) * DM + col0 + bj * 128 + n * 16);
#pragma unroll
                for (int m = 0; m < 4; ++m)
#pragma unroll
                    for (int bj = 0; bj < 2; ++bj)
#pragma unroll
                        for (int n = 0; n < 2; ++n) bb[m][bj][n] = (pg8::f32x4){bflo(rw[m][bj][n].x), bfhi(rw[m][bj][n].x), bflo(rw[m][bj][n].y), bfhi(rw[m][bj][n].y)};
            }
#pragma unroll
            for (int m = 0; m < 4; ++m) { const size_t off = (size_t)(row0 + ai * 128 + m * 16) * DM + col0; float ss = 0.f;
#pragma unroll
                for (int bj = 0; bj < 2; ++bj)
#pragma unroll
                    for (int n = 0; n < 2; ++n) { const pg8::f32x4 o = bb[m][bj][n] + acc[ai][bj][m][n];
                        ss += (o[0] * o[0] + o[1] * o[1]) + (o[2] * o[2] + o[3] * o[3]);
                        if (out32) *(pg8::f32x4*)(out32 + off + bj * 128 + n * 16) = o;
                        if (XB) { v2u w; w.x = pg8::cvt_pk_bf16(o[0], o[1]); w.y = pg8::cvt_pk_bf16(o[2], o[3]); *(v2u*)(XB + off + bj * 128 + n * 16) = w; }
                        if (X8) *(unsigned*)(X8 + off + bj * 128 + n * 16) = f8x4(o[0], o[1], o[2], o[3]); }
                ss += shx(ss, lane, 16); ss += shx(ss, lane, 32);
                if (fq == 0) xl[(wr * 64 + ai * 128 + m * 16 + fr) * 4 + wc] = ss; } }
        asm volatile("s_waitcnt lgkmcnt(0)" ::: "memory"); __builtin_amdgcn_s_barrier(); asm volatile("" ::: "memory");
        if (wc == 0 && fq == 0) {
#pragma unroll
            for (int ai = 0; ai < 2; ++ai)
#pragma unroll
                for (int m = 0; m < 4; ++m) { const int rl = wr * 64 + ai * 128 + m * 16 + fr; const pg8::f32x4 p = *(const LAS pg8::f32x4*)(xl + rl * 4);
                    RSS[(size_t)(u.pm * 256 + rl) * 8 + u.pn] = (p[0] + p[1]) + (p[2] + p[3]); } }
    }
};
struct EpiRelu2 {
    static constexpr bool PERM = true, SEGMENTS = false;
    bf16* O; const float* RSS; LAS float* rl; int ldc, pad;
    __device__ __forceinline__ void operator()(const pg8::f32x4 (&acc)[2][2][4][2], const pg8::Unit& u, int wr, int wc, int fr, int fq) const {
        const int row0 = u.pm * 256 + wr * 64 + fr, col0 = u.pn * 256 + wc * 32 + 8 * fq;
        if (wr == 0) rl[wc * 64 + fr + 16 * fq] = row_rinv(RSS + (size_t)(u.pm * 256 + wc * 64 + fr + 16 * fq) * 8);
        asm volatile("s_waitcnt lgkmcnt(0)" ::: "memory"); __builtin_amdgcn_s_barrier(); asm volatile("" ::: "memory");
#pragma unroll
        for (int ai = 0; ai < 2; ++ai)
#pragma unroll
            for (int m = 0; m < 4; ++m) { bf16* rowp = O + (size_t)(row0 + ai * 128 + m * 16) * ldc + col0; const float ri = rl[wr * 64 + ai * 128 + m * 16 + fr];
#pragma unroll
                for (int bj = 0; bj < 2; ++bj) { pg8::f32x4 v0 = acc[ai][bj][m][0] * ri, v1 = acc[ai][bj][m][1] * ri;
#pragma unroll
                    for (int j = 0; j < 4; ++j) { const float a = fmaxf(v0[j], 0.f), b = fmaxf(v1[j], 0.f); v0[j] = a * a; v1[j] = b * b; }
                    if (u.pn * 256 >= FF_B16) {
                        v2u w8; w8.x = f8x4(v0[0] * 8.f, v0[1] * 8.f, v0[2] * 8.f, v0[3] * 8.f); w8.y = f8x4(v1[0] * 8.f, v1[1] * 8.f, v1[2] * 8.f, v1[3] * 8.f);
                        *(v2u*)((unsigned char*)O + (size_t)(row0 + ai * 128 + m * 16) * (ldc * 2) + FF_B16 * 2 + (col0 - FF_B16) + bj * 128) = w8; continue; }
                    v4u w; w.x = pg8::cvt_pk_bf16(v0[0], v0[1]); w.y = pg8::cvt_pk_bf16(v0[2], v0[3]); w.z = pg8::cvt_pk_bf16(v1[0], v1[1]); w.w = pg8::cvt_pk_bf16(v1[2], v1[3]);
                    *(v4u*)(rowp + bj * 128) = w; } }
    }
};
__device__ __forceinline__ int colmap_in(int np) { return np < 2048 ? np : (np < 2560 ? np + 3072 : (np < 2632 ? np + 3072 : -1)); }
__device__ __forceinline__ int colmap_f8(int np) { return np < 3072 ? np + 2048 : np - 3072 + GATE_REF0; }
template <bool INMAP>
__device__ __forceinline__ void transpose_item(const float* W, int Nsrc, bf16* WT, int ldk, int koff, int k0, int n0, int lane, const float* gain = nullptr) {
    const int nq = lane & 15, kg = lane >> 4, np = n0 + 4 * nq; const int sc = INMAP ? colmap_in(np) : np;
    f32x4 v[16];
    if (sc >= 0) { const float* src = W + (size_t)(k0 + 16 * kg) * Nsrc + sc;
#pragma unroll
        for (int i = 0; i < 16; ++i) v[i] = __builtin_nontemporal_load((const f32x4*)(src + (size_t)i * Nsrc));
        if (gain) {
#pragma unroll
            for (int i = 0; i < 16; ++i) v[i] *= gain[k0 + 16 * kg + i]; } }
    else {
#pragma unroll
        for (int i = 0; i < 16; ++i) v[i] = (f32x4){0.f, 0.f, 0.f, 0.f}; }
#pragma unroll
    for (int j = 0; j < 4; ++j) { bf16* dst = WT + (size_t)(np + j) * ldk + koff + k0 + 16 * kg;
        v4u o0, o1;
        o0.x = pk2(v[0][j], v[1][j]); o0.y = pk2(v[2][j], v[3][j]); o0.z = pk2(v[4][j], v[5][j]); o0.w = pk2(v[6][j], v[7][j]);
        o1.x = pk2(v[8][j], v[9][j]); o1.y = pk2(v[10][j], v[11][j]); o1.z = pk2(v[12][j], v[13][j]); o1.w = pk2(v[14][j], v[15][j]);
        *(v4u*)dst = o0; *(v4u*)(dst + 8) = o1; }
}
template <bool INQ>
__device__ __forceinline__ void transpose_item_f8(const float* W, int Nsrc, unsigned char* W8, size_t rowb, int koffb, int k0, int n0, int lane, const float* gain, float scale) {
    const int nq = lane & 15, kg = lane >> 4, np = n0 + 4 * nq;
    const float* src = W + (size_t)(k0 + 16 * kg) * Nsrc + (INQ ? colmap_f8(np) : np);
    f32x4 v[16];
#pragma unroll
    for (int i = 0; i < 16; ++i) v[i] = __builtin_nontemporal_load((const f32x4*)(src + (size_t)i * Nsrc));
#pragma unroll
    for (int i = 0; i < 16; ++i) v[i] *= (gain ? gain[k0 + 16 * kg + i] : 1.f) * scale;
#pragma unroll
    for (int j = 0; j < 4; ++j) { v4u o; o.x = f8x4(v[0][j], v[1][j], v[2][j], v[3][j]); o.y = f8x4(v[4][j], v[5][j], v[6][j], v[7][j]); o.z = f8x4(v[8][j], v[9][j], v[10][j], v[11][j]); o.w = f8x4(v[12][j], v[13][j], v[14][j], v[15][j]);
        *(v4u*)(W8 + (size_t)(np + j) * rowb + koffb + k0 + 16 * kg) = o; }
}
__device__ __forceinline__ void convert_w2_item(const float* w_ff2, unsigned char* ws, int l, int r, int lane) {
    unsigned char* wl = ws + WS_W + (size_t)l * WL_STRIDE; const int nb = DM / 64, k0 = 64 * (r / nb), n0 = 64 * (r % nb);
    if (k0 < FF_B16) transpose_item<false>(w_ff2 + (size_t)l * DFF * DM, DM, (bf16*)(wl + WL_W2), FROW, 0, k0, n0, lane);
    else transpose_item_f8<false>(w_ff2 + (size_t)l * DFF * DM, DM, wl + WL_W2, (size_t)FROW * 2, FF_B16 * 2 - FF_B16, k0, n0, lane, nullptr, 32.f);
}
struct ConvArgs { const float *w_in, *w_conv_out, *w_attn_out, *w_o, *w_ff1, *w_ff2, *norm1, *norm2; unsigned char* ws; };
__device__ __forceinline__ void convert_weights(const ConvArgs& a, int gw, int NGW, int lane, bool defer_w2) {
    constexpr int I_IN = (DM / 64) * (NB16 / 64), I_G8 = (DM / 64) * (NF8 / 64), I_CO = (512 / 64) * (DM / 64), I_AO = (1024 / 64) * (DM / 64), I_WO = (DM / 64) * (DM / 64), I_1 = (DM / 64) * (DFF / 64), I_2 = (DFF / 64) * (DM / 64);
    constexpr int PER_L = I_IN + I_G8 + I_CO + I_AO + I_WO + I_1 + I_2;
    for (int it = gw; it < DEPTH * PER_L; it += NGW) {
        const int l = it / PER_L; int r = it - l * PER_L;
        unsigned char* wl = a.ws + WS_W + (size_t)l * WL_STRIDE;
        if (r < I_IN) { const int nb = NB16 / 64; transpose_item<true>(a.w_in + (size_t)l * DM * INW, INW, (bf16*)(wl + WL_WIN), DM, 0, 64 * (r / nb), 64 * (r % nb), lane, a.norm1 + (size_t)l * DM); continue; } r -= I_IN;
        if (r < I_G8) { const int nb = NF8 / 64; transpose_item_f8<true>(a.w_in + (size_t)l * DM * INW, INW, a.ws + WS_WG8 + (size_t)l * NF8 * DM, DM, 0, 64 * (r / nb), 64 * (r % nb), lane, a.norm1 + (size_t)l * DM, 32.f); continue; } r -= I_G8;
        if (r < I_CO) { const int nb = DM / 64; transpose_item<false>(a.w_conv_out + (size_t)l * 512 * DM, DM, (bf16*)(wl + WL_WCAT), MROW, 512, 64 * (r / nb), 64 * (r % nb), lane); continue; } r -= I_CO;
        if (r < I_AO) { const int nb = DM / 64; transpose_item_f8<false>(a.w_attn_out + (size_t)l * 1024 * DM, DM, wl + WL_WCAT, (size_t)MROW * 2, 2048, 64 * (r / nb), 64 * (r % nb), lane, nullptr, 32.f); continue; } r -= I_AO;
        if (r < I_WO) { const int nb = DM / 64; transpose_item<false>(a.w_o + (size_t)l * DM * DM, DM, (bf16*)(wl + WL_WO), DM, 0, 64 * (r / nb), 64 * (r % nb), lane); continue; } r -= I_WO;
        if (r < I_1) { const int nb = DFF / 64; transpose_item<false>(a.w_ff1 + (size_t)l * DM * DFF, DFF, (bf16*)(wl + WL_W1), DM, 0, 64 * (r / nb), 64 * (r % nb), lane, a.norm2 + (size_t)l * DM); continue; } r -= I_1;
        if (!defer_w2) convert_w2_item(a.w_ff2, a.ws, l, r, lane);
    }
}
__device__ __forceinline__ void fold_pool(const float* pool_w, const float* pool_scale, const float* w_pool_out, unsigned char* ws, int gw, int NGW, int lane) {
    for (int it = gw; it < DEPTH * 4 * 16 * 8; it += NGW) {
        const int dblk = it & 7, cib = (it >> 3) & 15, g = (it >> 7) & 3, l = it >> 9;
        const float* pw = pool_w + ((size_t)(l * 4 + g) * 128 + cib * 8) * 128; const float* ps = pool_scale + (size_t)l * 512 + g * 128;
        const float* wo = w_pool_out + ((size_t)l * 512 + g * 128) * DM + dblk * 256 + lane * 4;
        f32x4 acc[8];
#pragma unroll
        for (int i = 0; i < 8; ++i) acc[i] = (f32x4){0.f, 0.f, 0.f, 0.f};
#pragma unroll 8
        for (int c = 0; c < 128; ++c) { const f32x4 b = *(const f32x4*)(wo + (size_t)c * DM) * ps[c];
#pragma unroll
            for (int i = 0; i < 8; ++i) acc[i] += b * pw[i * 128 + c]; }
        bf16* dst = (bf16*)(ws + WS_W + (size_t)l * WL_STRIDE + WL_WCAT) + (size_t)(dblk * 256 + lane * 4) * MROW + g * 128 + cib * 8;
#pragma unroll
        for (int j = 0; j < 4; ++j) { v4u o; o.x = pk2(acc[0][j], acc[1][j]); o.y = pk2(acc[2][j], acc[3][j]); o.z = pk2(acc[4][j], acc[5][j]); o.w = pk2(acc[6][j], acc[7][j]);
            *(v4u*)(dst + (size_t)j * MROW) = o; }
    }
}

constexpr size_t WS_RSS = WS_WI + 512 * 1024;
__device__ __forceinline__ void xb_row(const float* xrow, bf16* orow, unsigned char* o8row, float* rss, int lane) {
    const f32x4* xr = (const f32x4*)xrow + lane;
    f32x4 v[8]; float s = 0.f;
#pragma unroll
    for (int j = 0; j < 8; ++j) { v[j] = xr[64 * j]; s += (v[j].x * v[j].x + v[j].y * v[j].y) + (v[j].z * v[j].z + v[j].w * v[j].w); }
    s = wave_sum(s, lane);
    v2u* o8 = (v2u*)orow + lane;
#pragma unroll
    for (int j = 0; j < 8; ++j) { v2u w; w.x = pk2(v[j].x, v[j].y); w.y = pk2(v[j].z, v[j].w); o8[64 * j] = w; ((unsigned*)o8row)[lane + 64 * j] = f8x4(v[j].x, v[j].y, v[j].z, v[j].w); }
    if (lane < 8) rss[lane] = (lane == 0) ? s : 0.f;
}

__device__ __forceinline__ void ld8(const bf16* p, float (&f)[8]) { const v4u w = *(const v4u*)p; f[0] = bflo(w.x); f[1] = bfhi(w.x); f[2] = bflo(w.y); f[3] = bfhi(w.y); f[4] = bflo(w.z); f[5] = bfhi(w.z); f[6] = bflo(w.w); f[7] = bfhi(w.w); }
__device__ __forceinline__ void st8(bf16* p, const float (&f)[8]) { v4u w; w.x = pk2(f[0], f[1]); w.y = pk2(f[2], f[3]); w.z = pk2(f[4], f[5]); w.w = pk2(f[6], f[7]); *(v4u*)p = w; }
__device__ __forceinline__ void prep_phase(const bf16* PC, const bf16* Q, const bf16* K, const bf16* V, unsigned char* Q8, unsigned char* K8, unsigned char* VT8, bf16* ACAT, const float* conv_w, const float* q_gain, const float* k_gain, size_t gtid, size_t nthreads) {
    for (size_t idx = gtid; idx < (size_t)SEQ * 64; idx += nthreads) {
        const int g = (int)((idx >> 6) & 3), c8 = g * 16 + (int)(idx & 15), t = (int)(idx >> 8) * 4 + (int)((idx >> 4) & 3);
        float cur[8], sum[8], v[8];
#define POOL_CASE(W) { v4u win[W]; \
            _Pragma("unroll") for (int j = 0; j < W; ++j) win[j] = *(const v4u*)(PC + (size_t)(t - j < 0 ? 0 : t - j) * 2048 + c8 * 8); \
            cur[0] = bflo(win[0].x); cur[1] = bfhi(win[0].x); cur[2] = bflo(win[0].y); cur[3] = bfhi(win[0].y); cur[4] = bflo(win[0].z); cur[5] = bfhi(win[0].z); cur[6] = bflo(win[0].w); cur[7] = bfhi(win[0].w); \
            _Pragma("unroll") for (int e = 0; e < 8; ++e) sum[e] = cur[e]; \
            _Pragma("unroll") for (int j = 1; j < W; ++j) { const float wj = (t - j >= 0) ? 1.f : 0.f; \
                sum[0] += wj * bflo(win[j].x); sum[1] += wj * bfhi(win[j].x); sum[2] += wj * bflo(win[j].y); sum[3] += wj * bfhi(win[j].y); \
                sum[4] += wj * bflo(win[j].z); sum[5] += wj * bfhi(win[j].z); sum[6] += wj * bflo(win[j].w); sum[7] += wj * bfhi(win[j].w); } }
        if (g == 0) POOL_CASE(2) else if (g == 1) POOL_CASE(4) else if (g == 2) POOL_CASE(8) else POOL_CASE(16)
#undef POOL_CASE
        const int w = 2 << g, cnt = (t + 1 < w) ? t + 1 : w; const float inv = 1.0f / (float)cnt;
#pragma unroll
        for (int e = 0; e < 8; ++e) v[e] = sum[e] * inv - cur[e];
        st8(ACAT + (size_t)t * MROW + c8 * 8, v);
    }
    for (size_t idx = gtid; idx < (size_t)SEQ * 64; idx += nthreads) {
        const int t = (int)(idx >> 6), c8 = (int)(idx & 63);
        float y[8], a[8], b[8];
#pragma unroll
        for (int e = 0; e < 8; ++e) y[e] = 0.f;
#pragma unroll
        for (int j = 0; j < 3; ++j) { const int tt = t - 2 + j; if (tt >= 0) { ld8(PC + (size_t)tt * 2048 + 1024 + c8 * 8, a); ld8(PC + (size_t)tt * 2048 + 1536 + c8 * 8, b);
#pragma unroll
                for (int e = 0; e < 8; ++e) y[e] += conv_w[j * 512 + c8 * 8 + e] * (a[e] * b[e]); } }
        ld8(PC + (size_t)t * 2048 + 512 + c8 * 8, a);
#pragma unroll
        for (int e = 0; e < 8; ++e) y[e] *= a[e];
        st8(ACAT + (size_t)t * MROW + 512 + c8 * 8, y);
    }
    { const int ln = (int)(gtid & 63), sg = ln >> 2, dc = ln & 3;
      for (size_t it = gtid >> 6; it < (size_t)(SEQ / 64) * 32; it += nthreads >> 6) {
          const int sblk = (int)(it >> 5), dblk = (int)(it & 31);
          const bf16* src = V + (size_t)(sblk * 64 + sg * 4) * 1024 + dblk * 32 + dc * 8;
          float f0[8], f1[8], f2[8], f3[8]; ld8(src, f0); ld8(src + 1024, f1); ld8(src + 2048, f2); ld8(src + 3072, f3);
          unsigned char* dst = VT8 + (size_t)(dblk * 32 + dc * 8) * SEQ + sblk * 64 + sg * 4;
#pragma unroll
          for (int e = 0; e < 8; ++e) *(unsigned*)(dst + (size_t)e * SEQ) = f8x4(f0[e], f1[e], f2[e], f3[e]); } }
}
__device__ __forceinline__ void score_phase(const bf16* QI, const bf16* KI, const float* WI, float* Sc, LAS unsigned char* lds, int bidx, int G, int tid) {
    const int wave = __builtin_amdgcn_readfirstlane(tid >> 6), lane = tid & 63, c = lane & 31, hi = lane >> 5;
    int par = 0;
#define SC_ITEM(it_, qb_, kc_) int qb_, kc_; { int g_ = 0; while (g_ < 7 && 16 * (g_ + 1) * (g_ + 2) <= (it_)) ++g_; const int r_ = (it_) - 16 * g_ * (g_ + 1), nk_ = g_ + 1; qb_ = g_ * 32 + r_ / nk_; kc_ = r_ % nk_; }
#define SC_STAGE(it_, p_) do { SC_ITEM(it_, qs_, ks_); (void)ks_; _Pragma("unroll") for (int j = 0; j < 4; ++j) { const int hk = wave + 8 * j; \
            __builtin_amdgcn_global_load_lds((const unsigned*)(QI + (size_t)(qs_ * 32 + (lane & 31)) * 512 + hk * 16 + (lane >> 5) * 8), (LAS unsigned*)(lds + (p_) * 32768 + hk * 1024), 16, 0, 0); } \
        if (wave < 4) __builtin_amdgcn_global_load_lds((const unsigned*)(WI + (size_t)qs_ * 256 + wave * 64 + lane), (LAS unsigned*)(lds + 65536 + (p_) * 1024 + wave * 256), 4, 0, 0); } while (0)
    bf16x8 kf[4][4];
#define SC_LDK(it_) do { SC_ITEM(it_, qk_, kk_); const int nad_ = ((qk_ >> 1) + 1) * 64, k0_ = kk_ * 1024 + wave * 128, k0c_ = k0_ < nad_ ? k0_ : 0; \
        _Pragma("unroll") for (int sub = 0; sub < 4; ++sub) _Pragma("unroll") for (int ks = 0; ks < 4; ++ks) kf[sub][ks] = *(const bf16x8*)(KI + (size_t)(k0c_ + sub * 32 + c) * 64 + ks * 16 + hi * 8); } while (0)
    if (bidx < 16 * 8 * 9) { SC_STAGE(bidx, 0); SC_LDK(bidx); }
    for (int it = bidx; it < 16 * 8 * 9; it += G, par ^= 1) {
        SC_ITEM(it, qb, kc); const int nadm = ((qb >> 1) + 1) * 64;
        LAS unsigned char* qbuf = lds + par * 32768;
        const int k0w = kc * 1024 + wave * 128; const bool act = k0w < nadm, more = it + G < 16 * 8 * 9;
        LAS float* wl = (LAS float*)(lds + 65536 + par * 1024);
        asm volatile("s_waitcnt vmcnt(0) lgkmcnt(0)" ::: "memory"); __syncthreads();
        if (more) SC_STAGE(it + G, par ^ 1);
        const int q = qb * 32 + c;
        f32x16 sacc[4], dA[2], dB[2]; float wcur = 0.f;
        if (act) {
#pragma unroll
            for (int sub = 0; sub < 4; ++sub)
#pragma unroll
                for (int r2 = 0; r2 < 16; ++r2) sacc[sub][r2] = 0.f;
#define SC_MMA(D, p, Q) do { _Pragma("unroll") for (int j_ = 0; j_ < 2; ++j_) _Pragma("unroll") for (int r_ = 0; r_ < 16; ++r_) D[j_][r_] = 0.f; \
        _Pragma("unroll") for (int ks_ = 0; ks_ < 4; ++ks_) _Pragma("unroll") for (int j_ = 0; j_ < 2; ++j_) D[j_] = __builtin_amdgcn_mfma_f32_32x32x16_bf16(kf[2 * (p) + j_][ks_], Q[ks_], D[j_], 0, 0, 0); } while (0)
#define SC_ACC(D, p, w) do { _Pragma("unroll") for (int j_ = 0; j_ < 2; ++j_) _Pragma("unroll") for (int r_ = 0; r_ < 16; ++r_) { const float x_ = D[j_][r_]; const int xi_ = __builtin_bit_cast(int, x_); const float t_ = __builtin_bit_cast(float, xi_ > 0 ? xi_ : 0); sacc[2 * (p) + j_][r_] += (w) * t_; } } while (0)
#define SC_MIX() do { _Pragma("unroll") for (int g_ = 0; g_ < 8; ++g_) { __builtin_amdgcn_sched_group_barrier(0x008, 1, 0); __builtin_amdgcn_sched_group_barrier(0x002, 6, 0); } } while (0)
            bf16x8 qf[4], qn[4];
            constexpr float WSC = 0.35355339059327373f * 0.125f;
            const unsigned qad = (unsigned)(uintptr_t)qbuf + (unsigned)lane * 16u, wad = (unsigned)(uintptr_t)wl + (unsigned)c * 32u;
#define SC_RDQ(dst, ad_) do { asm volatile("ds_read_b128 %0, %1" : "=&v"(dst[0]) : "v"(ad_) : "memory"); asm volatile("ds_read_b128 %0, %1 offset:1024" : "=&v"(dst[1]) : "v"(ad_) : "memory"); \
            asm volatile("ds_read_b128 %0, %1 offset:2048" : "=&v"(dst[2]) : "v"(ad_) : "memory"); asm volatile("ds_read_b128 %0, %1 offset:3072" : "=&v"(dst[3]) : "v"(ad_) : "memory"); } while (0)
#define SC_RDW(dst, ad_) asm volatile("ds_read_b32 %0, %1" : "=&v"(dst) : "v"(ad_) : "memory")
#define SC_LWAIT(q_, w_) asm volatile("s_waitcnt lgkmcnt(0)" : "+v"(q_[0]), "+v"(q_[1]), "+v"(q_[2]), "+v"(q_[3]), "+v"(w_) :: "memory")
            SC_RDQ(qf, qad); SC_RDW(wcur, wad); SC_LWAIT(qf, wcur); wcur *= WSC;
            SC_MMA(dA, 0, qf);
            __builtin_amdgcn_sched_barrier(0);
#pragma unroll 1
            for (int h = 0; h < 7; ++h) {
                float wnx; { const unsigned qa_ = qad + (unsigned)(h + 1) * 4096u, wa_ = wad + (unsigned)(h + 1) * 4u; SC_RDQ(qn, qa_); SC_RDW(wnx, wa_); }
                SC_MMA(dB, 1, qf); SC_ACC(dA, 0, wcur); SC_MIX();
                __builtin_amdgcn_sched_barrier(0);
                SC_LWAIT(qn, wnx); wnx *= WSC;
                SC_MMA(dA, 0, qn); SC_ACC(dB, 1, wcur); SC_MIX();
                __builtin_amdgcn_sched_barrier(0);
#pragma unroll
                for (int ks = 0; ks < 4; ++ks) qf[ks] = qn[ks];
                wcur = wnx;
            }
            SC_MMA(dB, 1, qf); SC_ACC(dA, 0, wcur); SC_MIX();
            __builtin_amdgcn_sched_barrier(0);
        }
        if (more) SC_LDK(it + G);
        __builtin_amdgcn_sched_barrier(0);
        if (act) {
            SC_ACC(dB, 1, wcur);
#undef SC_MMA
#undef SC_ACC
#undef SC_MIX
#undef SC_RDQ
#undef SC_RDW
#undef SC_LWAIT
            { typedef _Float16 h2_t __attribute__((ext_vector_type(2))); typedef short s2_t __attribute__((ext_vector_type(2))); typedef float f2_t __attribute__((ext_vector_type(2)));
#define SC_KEYS(sub_, j_, e2_) __builtin_bit_cast(unsigned, (s2_t)(__builtin_bit_cast(s2_t, __builtin_convertvector((f2_t){sacc[sub_][4 * (j_) + 2 * (e2_)] + 0.0f, sacc[sub_][4 * (j_) + 2 * (e2_) + 1] + 0.0f}, h2_t))))
#define SC_KEY2(sub_, j_, e2_) ({ const s2_t b_ = __builtin_bit_cast(s2_t, SC_KEYS(sub_, j_, e2_)); __builtin_bit_cast(unsigned, (s2_t)(b_ ^ ((b_ >> (short)15) | (s2_t){(short)0x8000, (short)0x8000}))); })
              unsigned short* sp = (unsigned short*)Sc + (size_t)q * SEQ + k0w + 8 * hi;
#pragma unroll
              for (int sub = 0; sub < 4; ++sub)
#pragma unroll
                  for (int jp = 0; jp < 2; ++jp) { const unsigned ax = SC_KEY2(sub, 2 * jp, 0), ay = SC_KEY2(sub, 2 * jp, 1), bx = SC_KEY2(sub, 2 * jp + 1, 0), by = SC_KEY2(sub, 2 * jp + 1, 1);
                      auto r0 = __builtin_amdgcn_permlane32_swap(ax, bx, false, false); auto r1 = __builtin_amdgcn_permlane32_swap(ay, by, false, false);
                      const v4u w = {r0[0], r1[0], r0[1], r1[1]};
                      *(v4u*)(sp + sub * 32 + 16 * jp) = w; }
#undef SC_KEY2
#undef SC_KEYS
            }
        }
    }
    __syncthreads();
#undef SC_LDK
#undef SC_STAGE
#undef SC_ITEM
}

constexpr int SEL_LDS_PER_WAVE = 2048 * 4 + 128 * 8;
__device__ __forceinline__ void hist_zero(LAS unsigned* hist, int lane) {
#pragma unroll
    for (int j = 0; j < 8; ++j) *(LAS v4u*)(hist + 32 * lane + 4 * j) = (v4u){0u, 0u, 0u, 0u};
    hist[2048 + lane] = 0u;
}
__device__ __forceinline__ void hist_scan(LAS unsigned* hist, unsigned need, int lane, unsigned& bsel, unsigned& above, unsigned& cntb) {
    v4u h[8]; unsigned s = 0u;
#pragma unroll
    for (int j = 0; j < 8; ++j) { h[j] = *(const LAS v4u*)(hist + 32 * lane + 4 * j); s += (h[j].x + h[j].y) + (h[j].z + h[j].w); }
    unsigned S = s;
#pragma unroll
    for (int o = 1; o < 64; o <<= 1) { const unsigned tt = (unsigned)shi((int)S, lane + o); if (lane + o < 64) S += tt; }
    const unsigned long long bal = __ballot(S >= need);
    const int lstar = bal ? 63 - __builtin_clzll(bal) : 0;
    unsigned run = S - s, ab = 0u, cb = 0u; int jb = 0; bool found = false;
#pragma unroll
    for (int j = 31; j >= 0; --j) { const unsigned c = h[j >> 2][j & 3]; if (!found && run + c >= need) { found = true; jb = j; ab = run; cb = c; } run += c; }
    bsel = (unsigned)shi(32 * lane + jb, lstar); above = (unsigned)shi((int)ab, lstar); cntb = (unsigned)shi((int)cb, lstar);
}
#define WLANE2(lo, hi, vlo, vhi, ln) asm("s_nop 4\n\tv_writelane_b32 %0, %2, %4\n\tv_writelane_b32 %1, %3, %4" : "+v"(lo), "+v"(hi) : "s"(vlo), "s"(vhi), "i"(ln))
template <int NG>
__device__ __forceinline__ void select_row_t(const unsigned* Sc, LAS unsigned* hist, int t, int nreg, int lane, unsigned long long& w0, unsigned long long& w1) {
    unsigned u[NG * 8];
    const unsigned short* row = (const unsigned short*)Sc + (size_t)t * SEQ + lane;
#pragma unroll
    for (int i = 0; i < NG * 8; ++i) u[i] = row[i * 64];
    unsigned g0 = 0u, g1 = 0u, g2 = 0u, g3 = 0u;
#pragma unroll
    for (int i = 0; i < NG * 8; ++i) { const unsigned k = (i < nreg) ? u[i] : 0u; u[i] = k;
        if ((i & 3) == 0) g0 = k > g0 ? k : g0; else if ((i & 3) == 1) g1 = k > g1 ? k : g1; else if ((i & 3) == 2) g2 = k > g2 ? k : g2; else g3 = k > g3 ? k : g3;
    }
    unsigned P = g0 < g1 ? g0 : g1; { const unsigned q = g2 < g3 ? g2 : g3; P = P < q ? P : q; }
    unsigned M = g0 > g1 ? g0 : g1; { const unsigned q = g2 > g3 ? g2 : g3; M = M > q ? M : q; }
#pragma unroll
    for (int o = 1; o < 64; o <<= 1) { const unsigned p2 = (unsigned)shi((int)P, lane ^ o), m2 = (unsigned)shi((int)M, lane ^ o); P = P < p2 ? P : p2; M = M > m2 ? M : m2; }
    unsigned base = P, top = M, need = 256u, T, n_eq, need_eq;
    const unsigned span0 = top - base; const int bits0 = span0 ? 32 - __builtin_clz(span0) : 0; int sh = bits0 > 11 ? bits0 - 11 : 0;
    hist_zero(hist, lane);
#pragma unroll
    for (int i0 = 0; i0 < NG * 8; i0 += 8) {
        if (pg8::opq_s(1)) {
#pragma unroll
            for (int i = i0; i < i0 + 8; ++i) { const unsigned bn = (u[i] - base) >> sh, dm = 2048u + (unsigned)lane;
                __hip_atomic_fetch_add(hist + (bn < dm ? bn : dm), 1u, __ATOMIC_RELAXED, __HIP_MEMORY_SCOPE_WAVEFRONT); } } }
    unsigned bsel, above, cnt; hist_scan(hist, need, lane, bsel, above, cnt);
    if (sh == 0) { T = base + bsel; n_eq = cnt; need_eq = need - above; }
    else {
        const unsigned base2 = base + (bsel << sh);
        LAS unsigned* H2 = hist + 64;
        hist_zero(hist, lane);
        const int lo = -1 - lane, hi = 2047;
#pragma unroll
        for (int i0 = 0; i0 < NG * 8; i0 += 8) {
            if (pg8::opq_s(1)) {
#pragma unroll
                for (int i = i0; i < i0 + 8; ++i) { const int d = (int)(u[i] - base2); int ix; asm("v_med3_i32 %0, %1, %2, %3" : "=v"(ix) : "v"(d), "v"(lo), "v"(hi));
                    __hip_atomic_fetch_add(H2 + ix, 1u, __ATOMIC_RELAXED, __HIP_MEMORY_SCOPE_WAVEFRONT); } } }
        hist_scan(H2, 256u, lane, bsel, above, cnt);
        T = base2 + bsel; n_eq = cnt; need_eq = 256u - above;
    }
    int w0l = 0, w0h = 0, w1l = 0, w1h = 0;
    if (n_eq == need_eq) {
#pragma unroll
        for (int i = 0; i < NG * 8; ++i) { const unsigned long long m = __ballot(u[i] >= T);
            const int mlo = (int)(unsigned)m, mhi = (int)(unsigned)(m >> 32);
            if (i < 64) WLANE2(w0l, w0h, mlo, mhi, i & 63); else WLANE2(w1l, w1h, mlo, mhi, i & 63); }
    } else {
        unsigned run = 0u;
#pragma unroll
        for (int i = 0; i < NG * 8; ++i) { const unsigned k = u[i]; const unsigned long long gt = __ballot(k > T), eq = __ballot(k == T);
            unsigned long long m = gt;
            if (eq) {
                const unsigned before = run + (unsigned)__builtin_popcountll(eq & ((1ull << lane) - 1ull));
                m |= __ballot(k == T && before < need_eq); run += (unsigned)__builtin_popcountll(eq); }
            const int mlo = (int)(unsigned)m, mhi = (int)(unsigned)(m >> 32);
            if (i < 64) WLANE2(w0l, w0h, mlo, mhi, i & 63); else WLANE2(w1l, w1h, mlo, mhi, i & 63); }
    }
    w0 = ((unsigned long long)(unsigned)w0h << 32) | (unsigned)w0l; w1 = ((unsigned long long)(unsigned)w1h << 32) | (unsigned)w1l;
}
__device__ __forceinline__ void select_row(const unsigned* Sc, unsigned long long* Mk, LAS unsigned* hist, int t, int lane) {
    const int nreg = t / 64 + 1;
    unsigned long long w0 = (lane < nreg && nreg <= 4) ? ~0ull : 0ull, w1 = 0ull;
    if (nreg > 4) {
        if (nreg <= 16) select_row_t<2>(Sc, hist, t, nreg, lane, w0, w1);
        else if (nreg <= 32) select_row_t<4>(Sc, hist, t, nreg, lane, w0, w1);
        else if (nreg <= 64) select_row_t<8>(Sc, hist, t, nreg, lane, w0, w1);
        else select_row_t<16>(Sc, hist, t, nreg, lane, w0, w1);
    }
    Mk[(size_t)t * 128 + lane] = w0; Mk[(size_t)t * 128 + 64 + lane] = w1;
}

namespace att {
constexpr int D = 128, PQ = 1024, PO = 2048, PM = 128;
constexpr float SCALE = 0.08838834764831845f, THR = 8.f;
constexpr int NW = 8, QBLK = 32, KVBLK = 64, QB = NW * QBLK;
constexpr int SHM_V = KVBLK * D, SHM_K = KVBLK * D;
constexpr int LDS_BYTES = 3 * SHM_V + 2 * SHM_K + NW * 64 * 4;
typedef short s16x4 __attribute__((ext_vector_type(4)));
typedef LAS char* lptr; typedef const LAS char* lcptr; typedef float f32x2v __attribute__((ext_vector_type(2)));
#define KSWZ(row, colB) ((row) * 256 + ((colB) ^ (((row) & 7) << 4)))
#define SBAR() __builtin_amdgcn_sched_barrier(0)
__device__ __forceinline__ int v_st(int k, int c) { const int kk = (k & ~0xC) | ((k & 4) << 1) | ((k & 8) >> 1); return ((kk >> 3) * 4 + (c >> 5)) * 512 + ((kk & 7) * 32 + (c & 31)) * 2; }
__device__ __forceinline__ int v_rd_base(int lane) { return ((lane & 3) << 3) | (((lane >> 2) & 3) << 6) | (((lane >> 4) & 1) << 5) | (((lane >> 5) & 1) << 8); }
constexpr int v_rd_off(int d0, int ks, int half) { return d0 * 512 + ks * 4096 + half * 2048; }
__device__ __forceinline__ int crow(int r, int hi) { return (r & 3) + 8 * (r >> 2) + 4 * hi; }
__device__ __forceinline__ unsigned cvtpk(float lo, float hi) { unsigned r; asm volatile("v_cvt_pk_bf16_f32 %0, %1, %2" : "=v"(r) : "v"(lo), "v"(hi)); return r; }
__device__ __forceinline__ bf16x8 load8(const bf16* p) { return *reinterpret_cast<const bf16x8*>(p); }
__device__ __forceinline__ float mask_and(float p, unsigned bits, int c) { int m; asm("v_bfe_i32 %0, %1, %2, 1" : "=v"(m) : "v"(bits), "i"(c)); return __builtin_bit_cast(float, __builtin_bit_cast(unsigned, p) & (unsigned)m); }
__device__ __forceinline__ void partialSM(f32x16& p0, f32x16& p1, float& m_reg, float& mn, float& alpha, unsigned bits0) {
    float pmax = p0[0];
#pragma unroll
    for (int r = 1; r < 16; ++r) pmax = fmaxf(pmax, p0[r]);
#pragma unroll
    for (int r = 0; r < 16; ++r) pmax = fmaxf(pmax, p1[r]);
    { auto rr = __builtin_amdgcn_permlane32_swap(__float_as_uint(pmax), __float_as_uint(pmax), false, false);
      pmax = fmaxf(__uint_as_float(rr[0]), __uint_as_float(rr[1])); }
    constexpr float C2 = 1.4426950408889634f * SCALE;
    const bool keep = __all((pmax - m_reg) * SCALE <= THR);
    mn = keep ? m_reg : fmaxf(m_reg, pmax); alpha = keep ? 1.f : __builtin_amdgcn_exp2f((m_reg - mn) * C2); m_reg = mn;
    const float mnL = -mn * C2;
#pragma unroll
    for (int r = 0; r < 16; ++r) p0[r] = fmaf(p0[r], C2, mnL);
#pragma unroll
    for (int r = 0; r < 16; ++r) p1[r] = fmaf(p1[r], C2, mnL);
#pragma unroll
    for (int r = 0; r < 16; ++r) p0[r] = mask_and(__builtin_amdgcn_exp2f(p0[r]), bits0, (r & 3) + 8 * (r >> 2));
}
__device__ __forceinline__ void finishSM(f32x16& p0, f32x16& p1, float alpha, float& l_reg, bf16x8& pa0, bf16x8& pa1, bf16x8& pa2, bf16x8& pa3, unsigned bits1) {
#pragma unroll
    for (int r = 0; r < 16; ++r) p1[r] = mask_and(__builtin_amdgcn_exp2f(p1[r]), bits1, (r & 3) + 8 * (r >> 2));
    float ps = 0;
#pragma unroll
    for (int r = 0; r < 16; ++r) ps += p0[r];
#pragma unroll
    for (int r = 0; r < 16; ++r) ps += p1[r];
    { auto rr = __builtin_amdgcn_permlane32_swap(__float_as_uint(ps), __float_as_uint(ps), false, false);
      ps = __uint_as_float(rr[0]) + __uint_as_float(rr[1]); }
    l_reg = l_reg * alpha + ps;
#define PK4(P, B_, OUT) do { unsigned a0 = cvtpk(P[B_+0], P[B_+1]), a1 = cvtpk(P[B_+2], P[B_+3]);                          \
        unsigned b0 = cvtpk(P[B_+4], P[B_+5]), b1 = cvtpk(P[B_+6], P[B_+7]);                                             \
        auto r0 = __builtin_amdgcn_permlane32_swap(a0, b0, false, false); auto r1 = __builtin_amdgcn_permlane32_swap(a1, b1, false, false); \
        v4u w = {r0[0], r1[0], r0[1], r1[1]}; OUT = __builtin_bit_cast(bf16x8, w); } while (0)
    PK4(p0, 0, pa0); PK4(p0, 8, pa1); PK4(p1, 0, pa2); PK4(p1, 8, pa3);
#undef PK4
}
template <int KB>
__device__ __forceinline__ void qkt(f32x16& p0, f32x16& p1, lcptr K_lds, int r32, int hi, const bf16x8* qr) {
#pragma unroll
    for (int r = 0; r < 16; ++r) { p0[r] = 0.f; p1[r] = 0.f; }
    lcptr kb[4];
#pragma unroll
    for (int dd = 0; dd < 4; ++dd) kb[dd] = K_lds + KB * SHM_K + KSWZ(r32, (dd * 16 + hi * 8) * 2);
#pragma unroll
    for (int d0 = 0; d0 < 8; ++d0) { lcptr a = kb[d0 & 3] + (d0 >> 2) * 128;
        bf16x8 b0 = *(const LAS bf16x8*)(a);
        bf16x8 b1 = *(const LAS bf16x8*)(a + 32 * 256);
        p0 = __builtin_amdgcn_mfma_f32_32x32x16_bf16(b0, qr[d0], p0, 0, 0, 0);
        p1 = __builtin_amdgcn_mfma_f32_32x32x16_bf16(b1, qr[d0], p1, 0, 0, 0); }
}
typedef int v8i __attribute__((ext_vector_type(8))); typedef int v4i __attribute__((ext_vector_type(4)));
template <int KB>
__device__ __forceinline__ void qkt8(f32x16& p0, f32x16& p1, const int (&kq)[4], const v8i* qf) {
#pragma unroll
    for (int r = 0; r < 16; ++r) { p0[r] = 0.f; p1[r] = 0.f; }
#define KRD8(i, j) (*(const LAS v4i*)(unsigned)(kq[i] + KB * SHM_K + (j) * 32 * 128))
#pragma unroll
    for (int m = 0; m < 2; ++m) {
        const v8i a0 = __builtin_shufflevector(KRD8(2 * m, 0), KRD8(2 * m + 1, 0), 0, 1, 2, 3, 4, 5, 6, 7);
        const v8i a1 = __builtin_shufflevector(KRD8(2 * m, 1), KRD8(2 * m + 1, 1), 0, 1, 2, 3, 4, 5, 6, 7);
        p0 = __builtin_amdgcn_mfma_scale_f32_32x32x64_f8f6f4(a0, qf[m], p0, 0, 0, 0, 0x7f7f7f7f, 0, 0x7f7f7f7f);
        p1 = __builtin_amdgcn_mfma_scale_f32_32x32x64_f8f6f4(a1, qf[m], p1, 0, 0, 0, 0x7f7f7f7f, 0, 0x7f7f7f7f); }
#undef KRD8
}
__device__ __forceinline__ void pv_tile(f32x16* o, int vb0, bf16x8 pa0, bf16x8 pa1, bf16x8 pa2, bf16x8 pa3) {
#define TRRD(dst, off) asm volatile("ds_read_b64_tr_b16 %0, %1 offset:%2" : "=&v"(dst) : "v"(vb0), "i"(off) : "memory")
#define PV_D0(d0) do { s16x4 l0, l1, l2, l3, h0, h1, h2, h3; constexpr int b_ = v_rd_off(d0, 0, 0); \
        TRRD(l0, b_); TRRD(h0, b_ + 2048); TRRD(l1, b_ + 4096); TRRD(h1, b_ + 6144); TRRD(l2, b_ + 8192); TRRD(h2, b_ + 10240); TRRD(l3, b_ + 12288); TRRD(h3, b_ + 14336); \
        asm volatile("s_waitcnt lgkmcnt(0)" : "+v"(l0), "+v"(h0), "+v"(l1), "+v"(h1), "+v"(l2), "+v"(h2), "+v"(l3), "+v"(h3) :: "memory"); \
        o[d0] = __builtin_amdgcn_mfma_f32_32x32x16_bf16(pa0, (bf16x8){l0[0], l0[1], l0[2], l0[3], h0[0], h0[1], h0[2], h0[3]}, o[d0], 0, 0, 0);   \
        o[d0] = __builtin_amdgcn_mfma_f32_32x32x16_bf16(pa1, (bf16x8){l1[0], l1[1], l1[2], l1[3], h1[0], h1[1], h1[2], h1[3]}, o[d0], 0, 0, 0);   \
        o[d0] = __builtin_amdgcn_mfma_f32_32x32x16_bf16(pa2, (bf16x8){l2[0], l2[1], l2[2], l2[3], h2[0], h2[1], h2[2], h2[3]}, o[d0], 0, 0, 0);   \
        o[d0] = __builtin_amdgcn_mfma_f32_32x32x16_bf16(pa3, (bf16x8){l3[0], l3[1], l3[2], l3[3], h3[0], h3[1], h3[2], h3[3]}, o[d0], 0, 0, 0); } while (0)
    PV_D0(0); PV_D0(1); PV_D0(2); PV_D0(3);
#undef PV_D0
#undef TRRD
}
__device__ __forceinline__ unsigned cvt4_e4m3(float a, float b, float c, float d) { int w = 0; w = __builtin_amdgcn_cvt_pk_fp8_f32(a, b, w, false); w = __builtin_amdgcn_cvt_pk_fp8_f32(c, d, w, true); return (unsigned)w; }
__device__ __forceinline__ void finishSM8(f32x16& p0, f32x16& p1, float alpha, float& l_reg, v8i& pA, unsigned bits1) {
#pragma unroll
    for (int r = 0; r < 16; ++r) p1[r] = mask_and(__builtin_amdgcn_exp2f(p1[r]), bits1, (r & 3) + 8 * (r >> 2));
    float ps = 0;
#pragma unroll
    for (int r = 0; r < 16; ++r) ps += p0[r];
#pragma unroll
    for (int r = 0; r < 16; ++r) ps += p1[r];
    { auto rr = __builtin_amdgcn_permlane32_swap(__float_as_uint(ps), __float_as_uint(ps), false, false);
      ps = __uint_as_float(rr[0]) + __uint_as_float(rr[1]); }
    l_reg = l_reg * alpha + ps;
#pragma unroll
    for (int i = 0; i < 4; ++i) { const unsigned x = cvt4_e4m3(p0[4 * i], p0[4 * i + 1], p0[4 * i + 2], p0[4 * i + 3]), y = cvt4_e4m3(p1[4 * i], p1[4 * i + 1], p1[4 * i + 2], p1[4 * i + 3]);
        auto rr = __builtin_amdgcn_permlane32_swap(x, y, false, false); pA[2 * i] = (int)rr[0]; pA[2 * i + 1] = (int)rr[1]; }
}
#define VRD(dst, addr, off) asm volatile("ds_read_b128 %0, %1 offset:%2" : "=&v"(dst) : "v"(addr), "i"(off) : "memory")
#define PV_RD(d0) v4i l##d0, h##d0; VRD(l##d0, vb0, d0 * 2048); VRD(h##d0, vb1, d0 * 2048);
#define PV_WT(d0, n) asm volatile("s_waitcnt lgkmcnt(%2)" : "+v"(l##d0), "+v"(h##d0) : "i"(n) : "memory")
#define PV_MM(d0) o[d0] = __builtin_amdgcn_mfma_scale_f32_32x32x64_f8f6f4(pA, __builtin_shufflevector(l##d0, h##d0, 0, 1, 2, 3, 4, 5, 6, 7), o[d0], 0, 0, 0, 0x7f7f7f7f, 0, 0x7f7f7f7f);
__device__ __forceinline__ void pv_tile8(f32x16* o, int vb0, int vb1, v8i pA) {
    PV_RD(0) PV_RD(1) PV_WT(0, 2); PV_MM(0) PV_RD(2) PV_WT(1, 2); PV_MM(1) PV_RD(3) PV_WT(2, 2); PV_MM(2) PV_WT(3, 0); PV_MM(3)
}
__device__ __forceinline__ void pv_sm8(f32x16* o, int vb0, int vb1, v8i pA, f32x16& p0, f32x16& p1, float& m_reg, float& mn, float& alpha, unsigned bits0) {
#define PV_END() do { __builtin_amdgcn_sched_group_barrier(0x008, 1, 0); SBAR(); } while (0)
    constexpr float C2 = 1.4426950408889634f * SCALE;
    PV_RD(0) PV_RD(1) PV_WT(0, 2); PV_MM(0)
    float pmax = p0[0];
#pragma unroll
    for (int r = 1; r < 16; ++r) pmax = fmaxf(pmax, p0[r]);
#pragma unroll
    for (int r = 0; r < 16; ++r) pmax = fmaxf(pmax, p1[r]);
    { auto rr = __builtin_amdgcn_permlane32_swap(__float_as_uint(pmax), __float_as_uint(pmax), false, false);
      pmax = fmaxf(__uint_as_float(rr[0]), __uint_as_float(rr[1])); }
    const bool keep = __all((pmax - m_reg) * SCALE <= THR);
    mn = keep ? m_reg : fmaxf(m_reg, pmax); alpha = keep ? 1.f : __builtin_amdgcn_exp2f((m_reg - mn) * C2); m_reg = mn;
    float mnL = -mn * C2;
    asm volatile("" : "+v"(mnL));
    PV_END();
    PV_RD(2) PV_WT(1, 2); PV_MM(1)
#pragma unroll
    for (int r = 0; r < 16; ++r) p0[r] = fmaf(p0[r], C2, mnL);
#pragma unroll
    for (int r = 0; r < 16; ++r) p1[r] = fmaf(p1[r], C2, mnL);
    asm volatile("" : "+v"(p0), "+v"(p1));
    PV_END();
    PV_RD(3) PV_WT(2, 2); PV_MM(2)
#pragma unroll
    for (int r = 0; r < 8; ++r) p0[r] = mask_and(__builtin_amdgcn_exp2f(p0[r]), bits0, (r & 3) + 8 * (r >> 2));
    asm volatile("" : "+v"(p0));
    PV_END();
    PV_WT(3, 0); PV_MM(3)
#pragma unroll
    for (int r = 8; r < 16; ++r) p0[r] = mask_and(__builtin_amdgcn_exp2f(p0[r]), bits0, (r & 3) + 8 * (r >> 2));
    asm volatile("" : "+v"(p0));
    PV_END();
#undef PV_END
}
#undef PV_RD
#undef PV_WT
#undef PV_MM
#undef VRD
struct BlockRef { const unsigned char* Q; const unsigned char* K; const unsigned char* V; bf16* OP; float* ML; const unsigned long long* M; int nt; };
struct Seam { v8i qf[2]; v2u mkA, mkB; int vs0; };
#define VMW() __builtin_amdgcn_s_waitcnt(0x0F70)
#define DMA_K(Kp, k0, bf) do { const char* kb_ = (const char*)((Kp) + (size_t)(k0) * 1024) + ksrc;                                                  \
        __builtin_amdgcn_global_load_lds((const unsigned*)kb_, (LAS unsigned*)(K_lds + (bf) * SHM_K + wid * 1024), 16, 0, 0); } while (0)
#define DMA_V(Vp, k0, slot) do { const char* vb_ = (const char*)(Vp) + (k0) + vsrc;                                                                \
        __builtin_amdgcn_global_load_lds((const unsigned*)vb_, (LAS unsigned*)(V_lds + (slot) * SHM_V + wid * 1024), 16, 0, 0); } while (0)
#define DMA_SRC() const unsigned ksrc = (unsigned)((wid * 8 + (lane >> 3)) * 1024 + (((lane & 7) ^ ((lane >> 3) & 7)) << 4));     \
        const unsigned vsrc = (unsigned)((wid * 16 + (lane >> 2)) * SEQ + (((lane & 3) ^ ((lane >> 3) & 3)) << 4))
#define MLOAD(ref, t) (*(const v2u*)((const char*)((ref).M + (t)) + (unsigned)((wid * QBLK + r32) * (PM * 8))))
__device__ __forceinline__ void prime(const BlockRef& cur, lptr lds, Seam& S, const int tid) {
    const int wid = __builtin_amdgcn_readfirstlane(tid >> 6), lane = tid & 63, r32 = lane & 31, hi = lane >> 5;
    lptr V_lds = lds; lptr K_lds = lds + 3 * SHM_V; DMA_SRC();
    { const unsigned qoff = (unsigned)((wid * QBLK + r32) * 1024 + hi * 32);
#pragma unroll
      for (int m = 0; m < 2; ++m) S.qf[m] = __builtin_shufflevector(*(const v4i*)(cur.Q + qoff + m * 64), *(const v4i*)(cur.Q + qoff + m * 64 + 16), 0, 1, 2, 3, 4, 5, 6, 7); }
    S.mkA = MLOAD(cur, 0); S.vs0 = 0;
    DMA_K(cur.K, 0, 0); DMA_V(cur.V, 0, 0); DMA_K(cur.K, KVBLK, 1); DMA_V(cur.V, KVBLK, 1); VMW();
    __syncthreads();
}
__device__ __forceinline__ void block(const BlockRef& cur, const BlockRef& nxt, lptr lds, Seam& S, const int tid) {
    const int wid = __builtin_amdgcn_readfirstlane(tid >> 6), lane = tid & 63, r32 = lane & 31, hi = lane >> 5;
    const int NT = cur.nt;
    lptr V_lds = lds; lptr K_lds = lds + 3 * SHM_V; DMA_SRC();
    LAS float* wsf = (LAS float*)(lds + 3 * SHM_V + 2 * SHM_K) + wid * 64; LAS float* al_l = wsf + 32;
    float m_reg = -1e30f, l_reg = 0; f32x16 o[4];
#pragma unroll
    for (int d = 0; d < 4; ++d)
#pragma unroll
        for (int r = 0; r < 16; ++r) o[d][r] = 0.f;
    const int vb0 = (int)(unsigned)(uintptr_t)V_lds + r32 * 64 + (((hi * 2) ^ ((r32 >> 1) & 3)) << 4);
    const unsigned char* Kh = cur.K; const unsigned char* Vh = cur.V;
    const int sh = 4 * hi;
    int kq[4];
#pragma unroll
    for (int i = 0; i < 4; ++i) { kq[i] = (int)(unsigned)(uintptr_t)K_lds + r32 * 128 + ((((hi * 2 + 4 * (i >> 1)) + (i & 1)) ^ (r32 & 7)) << 4); asm volatile("" : "+v"(kq[i])); }
    int va = S.vs0, vb = va == 2 ? 0 : va + 1, vc = vb == 2 ? 0 : vb + 1;
#define RESC(a) do { if (__any((a) < 1.f)) { if (hi == 0) al_l[r32] = (a); asm volatile("s_waitcnt lgkmcnt(0)" ::: "memory");              \
                     for (int d_ = 0; d_ < 4; ++d_) for (int r = 0; r < 16; ++r) o[d_][r] *= al_l[crow(r, hi)]; } } while (0)
#define KBASE(t) ((t) * KVBLK)
    f32x16 pA0, pA1, pB0, pB1; float mnA, mnB, alA, alB; v8i pP;
    S.mkB = MLOAD(cur, 1);
    SBAR(); qkt8<0>(pA0, pA1, kq, S.qf);
    partialSM(pA0, pA1, m_reg, mnA, alA, S.mkA.x >> sh);
    VMW(); __syncthreads();
#define HALF_STEP(PX0, PX1, mnX, alX, mkX, PY0, PY1, alY, mkY, t, KB, SB) do {                                                \
        SBAR(); qkt8<KB>(PX0, PX1, kq, S.qf);                                                                                 \
        finishSM8(PY0, PY1, alY, l_reg, pP, mkY.y >> sh); SBAR();                                                             \
        DMA_K(Kh, KBASE((t) + 1), SB); DMA_V(Vh, KBASE((t) + 1), vc); mkY = MLOAD(cur, (t) + 1);                              \
        { int vbs_ = vb0 + va * SHM_V; unsigned bts_ = mkX.x >> sh; asm volatile("" : "+v"(vbs_), "+v"(bts_)); SBAR();        \
          pv_sm8(o, vbs_, vbs_ ^ 16, pP, PX0, PX1, m_reg, mnX, alX, bts_); }                                                  \
        RESC(alX); VMW(); __syncthreads();                                                                                    \
        { const int t_ = va; va = vb; vb = vc; vc = t_; } } while (0)
    for (int t = 1; t + 1 < NT; t += 2) {
        HALF_STEP(pB0, pB1, mnB, alB, S.mkB, pA0, pA1, alA, S.mkA, t, 1, 0);
        HALF_STEP(pA0, pA1, mnA, alA, S.mkA, pB0, pB1, alB, S.mkB, t + 1, 0, 1);
    }
    SBAR(); qkt8<1>(pB0, pB1, kq, S.qf);
    finishSM8(pA0, pA1, alA, l_reg, pP, S.mkA.y >> sh); SBAR();
    DMA_K(nxt.K, 0, 0); DMA_V(nxt.V, 0, vc); SBAR();
    { const int ln_ = pg8::opq_v(lane); const unsigned qoff = (unsigned)((wid * QBLK + (ln_ & 31)) * 1024 + (ln_ >> 5) * 32);
#pragma unroll
      for (int m = 0; m < 2; ++m) S.qf[m] = __builtin_shufflevector(*(const v4i*)(nxt.Q + qoff + m * 64), *(const v4i*)(nxt.Q + qoff + m * 64 + 16), 0, 1, 2, 3, 4, 5, 6, 7); }
    S.mkA = MLOAD(nxt, 0);
    { int vbs_ = vb0 + va * SHM_V; unsigned bts_ = S.mkB.x >> sh; asm volatile("" : "+v"(vbs_), "+v"(bts_)); SBAR();
      pv_sm8(o, vbs_, vbs_ ^ 16, pP, pB0, pB1, m_reg, mnB, alB, bts_); }
    RESC(alB); VMW(); __syncthreads();
    DMA_K(nxt.K, KVBLK, 1); DMA_V(nxt.V, KVBLK, va); SBAR();
    finishSM8(pB0, pB1, alB, l_reg, pP, S.mkB.y >> sh); SBAR(); pv_tile8(o, vb0 + vb * SHM_V, (vb0 + vb * SHM_V) ^ 16, pP);
    SBAR(); VMW(); SBAR();
    S.vs0 = vc;
    { const int ln_ = pg8::opq_v(lane), r32e = ln_ & 31, hie = ln_ >> 5;
      if (hie == 0) { *(f32x2v*)((char*)cur.ML + (unsigned)((wid * QBLK + r32e) * 8)) = (f32x2v){m_reg, l_reg}; }
      lptr ot = lds + 49152 + wid * 8704;
#pragma unroll
      for (int r = 0; r < 16; ++r)
#pragma unroll
          for (int d0 = 0; d0 < 4; ++d0) *(LAS bf16*)(ot + ((r & 3) + 8 * (r >> 2) + 4 * hie) * 272 + (d0 * 32 + r32e) * 2) = (bf16)f2bf(o[d0][r]);
      asm volatile("s_waitcnt lgkmcnt(0)" ::: "memory");
      char* Ow = (char*)cur.OP + (unsigned)(wid * QBLK * D * 2);
#pragma unroll
      for (int i2 = 0; i2 < 8; ++i2) { const int p = i2 * 64 + ln_, row = p >> 4, pc = p & 15;
          *(v4u*)(Ow + row * 256 + pc * 16) = *(const LAS v4u*)(ot + row * 272 + pc * 16); } }
    __builtin_amdgcn_s_barrier();
#undef RESC
#undef KBASE
#undef HALF_STEP
}
#undef DMA_K
#undef DMA_V
#undef DMA_SRC
#undef VMW
#undef MLOAD
#undef KSWZ
#undef SBAR
}

#define XB_TMO      128
#define XB_XCNT(j)  (256  + 64 * (j))
#define XB_XSUB(j)  (1280 + 64 * (j))
#define XB_XGEN(j)  (2304 + 64 * (j))
#define XB_TOP      3328
#define XB_TOPGEN   3392
#define XCD_BAR_WORDS 3456
#define XB_SPIN_CAP (1u << 18)
typedef __attribute__((address_space(1))) unsigned gu32;
__device__ __forceinline__ unsigned xb_ld(unsigned* p)              { return __hip_atomic_load((gu32*)p, __ATOMIC_RELAXED, __HIP_MEMORY_SCOPE_AGENT); }
__device__ __forceinline__ unsigned xb_add(unsigned* p, unsigned v) { return __hip_atomic_fetch_add((gu32*)p, v, __ATOMIC_RELAXED, __HIP_MEMORY_SCOPE_AGENT); }
__device__ __forceinline__ unsigned xb_xcc_id() { return (unsigned)__builtin_amdgcn_s_getreg((3 << 11) | 20) & 0xFu; }
#define XB_SPIN(cond, bar) do { unsigned _sp = 0; while (cond) { __builtin_amdgcn_s_sleep(1); \
    if ((++_sp & 255u) == 0u) { if (xb_ld(&(bar)[XB_TMO])) break; if (_sp > XB_SPIN_CAP) { (void)xb_add(&(bar)[XB_TMO], 1u); break; } } } } while (0)
struct XcdBarrier { unsigned* bar; unsigned x; volatile LAS unsigned* st; unsigned w0; };
__device__ __forceinline__ bool xb_thread0(unsigned w0) { return w0 != 0u && pg8::lane_now() == 0; }
__device__ __forceinline__ XcdBarrier xcd_barrier_post(unsigned* bar, volatile LAS unsigned* st, unsigned w0) {
    XcdBarrier b; b.bar = bar; b.x = xb_xcc_id(); b.st = st; b.w0 = w0;
    if (xb_thread0(w0)) (void)xb_add(&bar[XB_XCNT(b.x)], 1u);
    return b;
}
__device__ __forceinline__ void xcd_barrier_complete(unsigned* bar, unsigned x, unsigned& nloc, unsigned& nx) {
    const unsigned G = gridDim.x * gridDim.y * gridDim.z;
    unsigned sum, cnt, mine, sp = 0u;
    for (;;) {
        sum = 0u; cnt = 0u; mine = 0u;
#pragma unroll
        for (unsigned j = 0; j < 16; ++j) { const unsigned c = xb_ld(&bar[XB_XCNT(j)]); sum += c; cnt += (c > 0u) ? 1u : 0u; mine = (j == x) ? c : mine; }
        if (sum == G) break;
        __builtin_amdgcn_s_sleep(1);
        if ((++sp & 255u) == 0u) { if (xb_ld(&bar[XB_TMO])) break; if (sp > XB_SPIN_CAP) { (void)xb_add(&bar[XB_TMO], 1u); break; } }
    }
    nloc = mine > 0u ? mine : 1u; nx = cnt > 0u ? cnt : 1u;
}
__device__ __forceinline__ void xcd_barrier(const XcdBarrier& b) {
    asm volatile("s_waitcnt vmcnt(0)" ::: "memory");
    __syncthreads();
    if (xb_thread0(b.w0)) {
        unsigned* bar = b.bar; unsigned bx = b.x;
        asm volatile("" : "+s"(bar), "+s"(bx)); bar = (unsigned*)(__attribute__((address_space(1))) unsigned*)bar;
        __builtin_amdgcn_s_waitcnt(0);
        unsigned nloc = b.st[0], nx = b.st[1];
        if (nloc == 0u) { xcd_barrier_complete(bar, bx, nloc, nx); b.st[0] = nloc; b.st[1] = nx; }
        const unsigned old = xb_add(&bar[XB_XSUB(bx)], 1u);
        const unsigned gen = old / nloc;
        if (old + 1u == (gen + 1u) * nloc) {
            __builtin_amdgcn_fence(__ATOMIC_RELEASE, "agent");
            asm volatile("s_waitcnt vmcnt(0)" ::: "memory");
            const unsigned og = xb_add(&bar[XB_TOP], 1u);
            const unsigned tg = og / nx;
            if (og + 1u == (tg + 1u) * nx) xb_add(&bar[XB_TOPGEN], 1u);
            else XB_SPIN(xb_ld(&bar[XB_TOPGEN]) == tg, bar);
            __builtin_amdgcn_fence(__ATOMIC_ACQUIRE, "agent");
            xb_add(&bar[XB_XGEN(bx)], 1u);
            asm volatile("s_waitcnt vmcnt(0)" ::: "memory");
        } else {
            XB_SPIN(xb_ld(&bar[XB_XGEN(bx)]) == gen, bar);
            __builtin_amdgcn_fence(__ATOMIC_ACQUIRE, "agent");
            asm volatile("s_waitcnt vmcnt(0)" ::: "memory");
        }
    }
    __syncthreads();
}

#ifndef RP_PRO
#define RP_PRO 1
#endif
#ifndef RP_ATT
#define RP_ATT 1
#endif
#ifndef RP_IDX
#define RP_IDX 1
#endif
#ifndef RP_SEL
#define RP_SEL 1
#endif
#ifndef RP_SEL2
#define RP_SEL2 1
#endif
#ifndef RP_MRG2
#define RP_MRG2 1
#endif
#ifndef RP_SC2
#define RP_SC2 1
#endif
#ifndef RP_INP
#define RP_INP 1
#endif
#ifndef RP_MRG
#define RP_MRG 1
#endif
#ifndef RP_FF1
#define RP_FF1 1
#endif
#ifndef RP_NRM
#define RP_NRM 1
#endif
constexpr int NWAVES = 8;
constexpr int RING_BYTES = 131072;
constexpr int LDSCTL_OFF = RING_BYTES;
constexpr int LDS_BYTES = 147456;
constexpr int CW_BAR = 4096;
struct MegaArgs { const float* in[15]; float* out; unsigned char* ws; };

template <class T> __device__ __forceinline__ T* asg(T* p) { return (T*)(__attribute__((address_space(1))) T*)p; }
typedef const __attribute__((address_space(4))) MegaArgs* KArgP;
__device__ __forceinline__ KArgP kargs() { KArgP q = (KArgP)__builtin_amdgcn_kernarg_segment_ptr(); asm volatile("" : "+s"(q)); return q; }

__global__ void __launch_bounds__(NWAVES * 64, 2) mega_fwd(MegaArgs a_unused) {
    extern __shared__ __attribute__((aligned(1024))) unsigned char lds_raw[];
    LAS unsigned char* lds = (LAS unsigned char*)lds_raw;
    const int tid = threadIdx.x, lane = tid & 63, wave = __builtin_amdgcn_readfirstlane(tid >> 6);
    const int G = gridDim.x, gw = blockIdx.x * NWAVES + wave, NGW = G * NWAVES;
    for (int u = tid; u < (LDS_BYTES - LDSCTL_OFF) / 4; u += NWAVES * 64) ((LAS unsigned*)(lds + LDSCTL_OFF))[u] = 0u;
    __syncthreads();
    XcdBarrier bar = xcd_barrier_post((unsigned*)(asg(kargs()->ws) + WS_CTL) + CW_BAR, (volatile LAS unsigned*)(lds + LDSCTL_OFF) + 8, wave == 0 ? 1u : 0u);
#define LANE pg8::lane_now()
#define TID (pg8::opq_s(wave) * 64 + pg8::lane_now())
#define GTID ((size_t)pg8::opq_s((int)blockIdx.x) * (NWAVES * 64) + (size_t)TID)
#define GW pg8::opq_s(gw)
#define BIDX pg8::opq_s((int)blockIdx.x)
#define NTHR ((size_t)gridDim.x * (NWAVES * 64))

    for (int rp = 0; rp < RP_PRO; ++rp) {
    { KArgP q = kargs(); ConvArgs ca{asg(q->in[2]), asg(q->in[9]), asg(q->in[10]), asg(q->in[11]), asg(q->in[13]), asg(q->in[14]), asg(q->in[1]), asg(q->in[12]), asg(q->ws)};
      convert_weights(ca, GW, NGW, LANE, G == 256); }
    { KArgP q = kargs(); fold_pool(asg(q->in[3]), asg(q->in[4]), asg(q->in[8]), asg(q->ws), GW, NGW, LANE); }
    { KArgP q = kargs(); unsigned char* ws = asg(q->ws); const float* x = asg(q->in[0]); const int ln = LANE;
      for (int m = GW; m < SEQ; m += NGW) xb_row(x + (size_t)m * DM, (bf16*)(ws + WS_HB) + (size_t)m * DM, ws + WS_X8 + (size_t)m * DM, (float*)(ws + WS_RSS) + (size_t)m * 8, ln); }
    xcd_barrier(bar); }

#pragma unroll 1
    for (int l = 0; l < DEPTH; ++l) {
        for (int rp = 0; rp < RP_INP; ++rp) {
        { KArgP q = kargs(); unsigned char* ws = asg(q->ws); unsigned char* wl = ws + WS_W + (size_t)l * WL_STRIDE;
          pg8::Gemm g{(const bf16*)(ws + WS_HB), (const bf16*)(wl + WL_WIN), SEQ, NB16, DM, DM, DM, 0}; pg8::StaticOrder S; S.init(SEQ, NB16, G, BIDX);
          EpiInProj E{(bf16*)(ws + WS_PC), (bf16*)(ws + WS_Q), (bf16*)(ws + WS_K), (bf16*)(ws + WS_V), (bf16*)(ws + WS_QI), (bf16*)(ws + WS_KI), (bf16*)(ws + WS_G), (float*)(ws + WS_WI), (const float*)(ws + WS_RSS), (LAS float*)(lds + RING_BYTES + 8192)};
          pg8::gemm_phase<EpiInProj, pg8::StaticOrder, true, true>(lds, g, S, E, TID); }
        { KArgP q = kargs(); unsigned char* ws = asg(q->ws);
          pg8::Gemm g{(const bf16*)(ws + WS_X8), (const bf16*)(ws + WS_WG8 + (size_t)l * NF8 * DM), SEQ, NF8, DM / 2, DM / 2, DM / 2, 0}; pg8::StaticOrder S; S.init(SEQ, NF8, G, G - 1 - BIDX);
          EpiGate E{(bf16*)(ws + WS_Q), (bf16*)(ws + WS_K), (bf16*)(ws + WS_V), (bf16*)(ws + WS_G), (const float*)(ws + WS_RSS), (LAS float*)(lds + RING_BYTES + 9216), ws + WS_X, asg(q->in[6]) + (size_t)l * 128, asg(q->in[7]) + (size_t)l * 128, (LAS float*)(lds + RING_BYTES + 256)};
          pg8::gemm_phase<EpiGate, pg8::StaticOrder, true, true, true>(lds, g, S, E, TID); }
        if (G == 256) { KArgP q = kargs(); const int cb = BIDX; const int nsh = cb < 96 ? 0 : (cb < 128 ? 2 : 1), s0 = cb < 128 ? 128 + 2 * (cb - 96) : cb - 128;
          const int lo = (s0 * 4096) / 192, hi = ((s0 + nsh) * 4096) / 192; const int ln = LANE;
          for (int r = lo + pg8::opq_s(wave); r < hi; r += NWAVES) convert_w2_item(asg(q->in[14]), asg(q->ws), l, r, ln); }
        xcd_barrier(bar); }
        for (int rp = 0; rp < RP_IDX; ++rp) {
        { KArgP q = kargs(); unsigned char* ws = asg(q->ws);
          prep_phase((const bf16*)(ws + WS_PC), (const bf16*)(ws + WS_Q), (const bf16*)(ws + WS_K), (const bf16*)(ws + WS_V), ws + WS_X, ws + WS_X + 8 * MiB, ws + WS_X + 16 * MiB, (bf16*)(ws + WS_ACAT), asg(q->in[5]) + (size_t)l * 3 * 512, asg(q->in[6]) + (size_t)l * 128, asg(q->in[7]) + (size_t)l * 128, GTID, NTHR); }
        { KArgP q = kargs(); unsigned char* ws = asg(q->ws);
          score_phase((const bf16*)(ws + WS_QI), (const bf16*)(ws + WS_KI), (const float*)(ws + WS_WI), (float*)(ws + WS_S), lds, BIDX, G, TID);
          if (RP_SC2 > 1) score_phase((const bf16*)(ws + WS_QI), (const bf16*)(ws + WS_KI), (const float*)(ws + WS_WI), (float*)(ws + WS_S), lds, BIDX, G, TID); }
        xcd_barrier(bar); }
        for (int rp = 0; rp < RP_SEL; ++rp) {
        { KArgP q = kargs(); unsigned char* ws = asg(q->ws); const unsigned* SC = (const unsigned*)(ws + WS_S); unsigned long long* MK = (unsigned long long*)(ws + WS_MASK);
          LAS unsigned* hist = (LAS unsigned*)(lds + wave * SEL_LDS_PER_WAVE);
          const int ln = LANE; int k = 0;
          for (int i0 = GW; i0 < SEQ * RP_SEL2; i0 += NGW, ++k) { const int i = i0 & (SEQ - 1); const int t = ((i ^ k) & 1) ? (SEQ - 1 - (i >> 1)) : (i >> 1); select_row(SC, MK, hist, t, ln); } }
        xcd_barrier(bar); }
        for (int rp = 0; rp < RP_ATT; ++rp) {
        { KArgP q = kargs(); unsigned char* ws = asg(q->ws);
          const unsigned char* Q8b = ws + WS_X; const unsigned char* K8b = ws + WS_X + 8 * MiB; const unsigned char* V8b = ws + WS_X + 16 * MiB; const unsigned long long* Mb = (const unsigned long long*)(ws + WS_MASK);
          bf16* OPb = (bf16*)(ws + WS_MF); float* MLb = (float*)(ws + WS_MB);
          att::Seam S; const int tida = TID;
          for (int c = BIDX; c < 256; c += G) {
              const int h = c & 7, x = c >> 3, half = x >> 4;
#define ATT_REF(qb_) att::BlockRef{Q8b + h * 128 + (size_t)(qb_) * 256 * 1024, K8b + h * 128 + (size_t)(half * 2 * ((qb_) + 1)) * 64 * 1024, V8b + (size_t)h * 128 * SEQ + (size_t)(half * 2 * ((qb_) + 1)) * 64, \
                  OPb + (size_t)((h * 32 + (qb_)) * 2 + half) * 256 * 128, MLb + (size_t)((h * 32 + (qb_)) * 2 + half) * 256 * 2, Mb + (size_t)(qb_) * 256 * att::PM + half * 2 * ((qb_) + 1), 2 * ((qb_) + 1)}
              const att::BlockRef u0 = ATT_REF(31 - x), u1 = ATT_REF(x);
              att::prime(u0, (att::lptr)lds, S, tida);
              att::block(u0, u1, (att::lptr)lds, S, tida);
              att::block(u1, u1, (att::lptr)lds, S, tida);
#undef ATT_REF
          } }
        xcd_barrier(bar); }
        { KArgP q = kargs(); unsigned char* ws = asg(q->ws); const bf16* OPb = (const bf16*)(ws + WS_MF); const float* MLb = (const float*)(ws + WS_MB); unsigned char* Ob = ws + WS_ACAT + 2048;
          constexpr float C2 = 1.4426950408889634f * att::SCALE;
          for (size_t idx = GTID; idx < (size_t)SEQ * 8 * 16; idx += NTHR) {
              const int c8 = (int)(idx & 15), h = (int)((idx >> 4) & 7), t = (int)(idx >> 7), qb = t >> 8, r = t & 255;
              const size_t u0 = (size_t)((h * 32 + qb) * 2) * 256 + r, u1 = u0 + 256;
              const att::f32x2v ml0 = *(const att::f32x2v*)(MLb + u0 * 2), ml1 = *(const att::f32x2v*)(MLb + u1 * 2);
              const float m = fmaxf(ml0.x, ml1.x), w0 = __builtin_amdgcn_exp2f((ml0.x - m) * C2), w1 = __builtin_amdgcn_exp2f((ml1.x - m) * C2);
              const float inv = 1.0f / (ml0.y * w0 + ml1.y * w1), a0 = w0 * inv, a1 = w1 * inv;
              float p[8], q8[8], v[8]; ld8(OPb + u0 * 128 + c8 * 8, p); ld8(OPb + u1 * 128 + c8 * 8, q8);
#pragma unroll
              for (int e = 0; e < 8; ++e) v[e] = p[e] * a0 + q8[e] * a1;
              v2u w8; w8.x = f8x4(v[0] * 16.f, v[1] * 16.f, v[2] * 16.f, v[3] * 16.f); w8.y = f8x4(v[4] * 16.f, v[5] * 16.f, v[6] * 16.f, v[7] * 16.f);
              *(v2u*)(Ob + (size_t)t * (MROW * 2) + h * 128 + c8 * 8) = w8; } }
        xcd_barrier(bar);
        for (int rp = 0; rp < RP_MRG; ++rp) {
        { KArgP q = kargs(); unsigned char* ws = asg(q->ws); unsigned char* wl = ws + WS_W + (size_t)l * WL_STRIDE;
          pg8::Gemm g{(const bf16*)(ws + WS_ACAT), (const bf16*)(wl + WL_WCAT), SEQ, DM, MROW, MROW, MROW, 0}; pg8::StaticOrder S; S.init(SEQ, DM, G, BIDX);
          EpiMerge E{(const bf16*)(ws + WS_G), (bf16*)(ws + WS_MB)};
          pg8::gemm_phase<EpiMerge, pg8::StaticOrder, false, true, 2>(lds, g, S, E, TID); }
        xcd_barrier(bar); }
        { KArgP q = kargs(); unsigned char* ws = asg(q->ws); unsigned char* wl = ws + WS_W + (size_t)l * WL_STRIDE;
          pg8::Gemm g{(const bf16*)(ws + WS_MB), (const bf16*)(wl + WL_WO), SEQ, DM, DM, DM, DM, 0}; pg8::StaticOrder S; S.init(SEQ, DM, G, BIDX);
          EpiResid E{(l == 0) ? asg(q->in[0]) : (const float*)nullptr, (const bf16*)(ws + WS_HB), (float*)nullptr, (bf16*)(ws + WS_HB), (unsigned char*)nullptr, (float*)(ws + WS_RSS), (LAS float*)(lds + RING_BYTES + 256)};
          pg8::gemm_phase<EpiResid, pg8::StaticOrder, false, true>(lds, g, S, E, TID); }
        xcd_barrier(bar);
        for (int rp = 0; rp < RP_FF1; ++rp) {
        { KArgP q = kargs(); unsigned char* ws = asg(q->ws); unsigned char* wl = ws + WS_W + (size_t)l * WL_STRIDE;
          pg8::Gemm g{(const bf16*)(ws + WS_HB), (const bf16*)(wl + WL_W1), SEQ, DFF, DM, DM, DM, 0}; pg8::StaticOrder S; S.init(SEQ, DFF, G, BIDX);
          EpiRelu2 E{(bf16*)(ws + WS_F), (const float*)(ws + WS_RSS), (LAS float*)(lds + RING_BYTES + 8192), FROW, 0};
          pg8::gemm_phase<EpiRelu2, pg8::StaticOrder, true, true>(lds, g, S, E, TID); }
        xcd_barrier(bar); }
        { KArgP q = kargs(); unsigned char* ws = asg(q->ws); unsigned char* wl = ws + WS_W + (size_t)l * WL_STRIDE;
          pg8::Gemm g{(const bf16*)(ws + WS_F), (const bf16*)(wl + WL_W2), SEQ, DM, FROW, FROW, FROW, 0}; pg8::StaticOrder S; S.init(SEQ, DM, G, BIDX);
          EpiResid E{(const float*)nullptr, (const bf16*)(ws + WS_HB), (l == DEPTH - 1) ? asg(q->out) : (float*)nullptr, (l == DEPTH - 1) ? (bf16*)nullptr : (bf16*)(ws + WS_HB), (l == DEPTH - 1) ? (unsigned char*)nullptr : ws + WS_X8, (float*)(ws + WS_RSS), (LAS float*)(lds + RING_BYTES + 256)};
          pg8::gemm_phase<EpiResid, pg8::StaticOrder, false, true, 2, FF_B16 / 64, 0x7b7b7b7b>(lds, g, S, E, TID);     }
        if (l + 1 < DEPTH) xcd_barrier(bar);
    }
#undef GTID
#undef TID
#undef LANE
#undef GW
#undef BIDX
#undef NTHR
}

extern "C" void kernel_launch(void* const* d_in, const int* in_sizes, int n_in, void* d_out, int out_size, void* d_ws, size_t ws_size, hipStream_t stream) {
    static int grid = 0;
    if (grid == 0) {
        if (n_in != 15 || in_sizes[0] != SEQ * DM || out_size != SEQ * DM || ws_size < WS_END) { fprintf(stderr, "kernel_launch: unexpected shapes / workspace (n_in %d, ws %zu, need %zu)\n", n_in, ws_size, (size_t)WS_END); grid = -1; return; }
        int dev = 0, cus = 0, per_cu = 0;
        if (hipGetDevice(&dev) != hipSuccess || hipDeviceGetAttribute(&cus, hipDeviceAttributeMultiprocessorCount, dev) != hipSuccess) { grid = -1; return; }
        if (hipFuncSetAttribute((const void*)mega_fwd, hipFuncAttributeMaxDynamicSharedMemorySize, LDS_BYTES) != hipSuccess) { fprintf(stderr, "kernel_launch: hipFuncSetAttribute failed\n"); grid = -1; return; }
        if (hipOccupancyMaxActiveBlocksPerMultiprocessor(&per_cu, (const void*)mega_fwd, NWAVES * 64, LDS_BYTES) != hipSuccess || per_cu < 1) { fprintf(stderr, "kernel_launch: occupancy query says %d blocks per CU\n", per_cu); }
        (void)hipGetLastError();
        grid = cus;
    }
    if (grid < 0) return;
    if (hipMemsetAsync((char*)d_ws + WS_CTL, 0, 1 * MiB, stream) != hipSuccess) { fprintf(stderr, "kernel_launch: memset failed\n"); return; }
    MegaArgs a{};
    for (int i = 0; i < 15; ++i) a.in[i] = (const float*)d_in[i];
    a.out = (float*)d_out; a.ws = (unsigned char*)d_ws;
    hipLaunchKernelGGL(mega_fwd, dim3(grid), dim3(NWAVES * 64), LDS_BYTES, stream, a);
}
```
